# Optimizing an MI355X kernel written in HIP

```python
import math
import jax, jax.numpy as jnp
from jax import lax
import numpy as np

D_MODEL = 1024
BATCH = 8
SEQ = 2048
DEPTH = 2

HEAD_DIM = 64
GLA_HEADS = 4
GLA_DK = 32
GLA_DV = 64
GLA_RANK = 16
GLA_TAU = 16.0
GLA_CHUNK = 64
DSA_HEADS = 4
IDX_HEADS = 8
IDX_DIM = 64
DSA_TOPK_MAX = 256
Q_BLOCK = 128
SWA_HEADS = 8
SWA_KV_HEADS = 2
SWA_GROUP = SWA_HEADS // SWA_KV_HEADS
WINDOW = 128
D_MIX = GLA_HEADS * GLA_DV + DSA_HEADS * HEAD_DIM + SWA_HEADS * HEAD_DIM
REL_BUCKETS = 32
REL_MAX_DIST = 128
BIAS_HEADS = DSA_HEADS + SWA_HEADS
N_GROUPS = 4
EXPERTS_PER_GROUP = 8
N_EXPERTS = N_GROUPS * EXPERTS_PER_GROUP
TOP_K_IN_GROUP = 2
D_EXPERT = 512
EXPERT_BLOCK = 128
PLE_DIM = 256
EPS = 1e-6
IN_SPLITS = (
    GLA_HEADS * GLA_DK, GLA_HEADS * GLA_DK, GLA_HEADS * GLA_DV, GLA_HEADS * GLA_DV, GLA_RANK,
    DSA_HEADS * HEAD_DIM, HEAD_DIM, HEAD_DIM, IDX_HEADS * IDX_DIM, IDX_DIM, IDX_HEADS,
    SWA_HEADS * HEAD_DIM, SWA_KV_HEADS * HEAD_DIM, SWA_KV_HEADS * HEAD_DIM,
)
D_IN = sum(IN_SPLITS)

kernel_name = 'hybrid_gla_dsa_swa_hmoe_block'


def rms_norm(x, g):
    xf = x.astype(jnp.float32)
    y = xf * lax.rsqrt(jnp.mean(xf * xf, axis=-1, keepdims=True) + EPS)
    return (y * g.astype(jnp.float32)).astype(x.dtype)


def rel_bucket(dist):
    n = jnp.maximum(dist, 0)
    max_exact = REL_BUCKETS // 2
    nf = jnp.maximum(n, 1).astype(jnp.float32)
    large = max_exact + (jnp.log(nf / max_exact) / math.log(REL_MAX_DIST / max_exact)
                         * (REL_BUCKETS - max_exact)).astype(jnp.int32)
    large = jnp.minimum(large, REL_BUCKETS - 1)
    return jnp.where(n < max_exact, n, large)


def gla_mixer(q, k, v, g, a_lr, w_alpha2, b_alpha, g_norm):
    f32 = jnp.float32
    B, L, _ = q.shape
    nc = L // GLA_CHUNK
    log_a = jax.nn.log_sigmoid((a_lr @ w_alpha2 + b_alpha).astype(f32)) / GLA_TAU

    def heads(t, d):
        t = t.astype(f32).reshape(B, nc, GLA_CHUNK, GLA_HEADS, d)
        return jnp.transpose(t, (1, 0, 3, 2, 4))

    qc = heads(q, GLA_DK) * GLA_DK ** -0.5
    kc = heads(k, GLA_DK)
    vc = heads(v, GLA_DV)
    bc = jnp.cumsum(heads(log_a, GLA_DK), axis=-2)
    causal = jnp.tril(jnp.ones((GLA_CHUNK, GLA_CHUNK), bool))[..., None]

    def step(state, inp):
        qi, ki, vi, bi = inp
        o_inter = jnp.einsum('bhtk,bhkv->bhtv', qi * jnp.exp(bi), state)
        diff = bi[:, :, :, None, :] - bi[:, :, None, :, :]
        decay = jnp.where(causal, jnp.exp(jnp.where(causal, diff, 0.0)), 0.0)
        scores = jnp.einsum('bhtk,bhsk,bhtsk->bhts', qi, ki, decay)
        o = o_inter + jnp.einsum('bhts,bhsv->bhtv', scores, vi)
        b_last = bi[:, :, -1:, :]
        state = (jnp.exp(b_last[:, :, 0, :])[..., None] * state
                 + jnp.einsum('bhsk,bhsv->bhkv', ki * jnp.exp(b_last - bi), vi))
        return state, o

    state0 = jnp.zeros((B, GLA_HEADS, GLA_DK, GLA_DV), f32)
    _, o = lax.scan(step, state0, (qc, kc, vc, bc))
    o = jnp.transpose(o, (1, 0, 3, 2, 4)).reshape(B, L, GLA_HEADS, GLA_DV)
    o = o * lax.rsqrt(jnp.mean(o * o, axis=-1, keepdims=True) + EPS) * g_norm.astype(f32)
    o = o.reshape(B, L, GLA_HEADS * GLA_DV) * jax.nn.silu(g.astype(f32))
    return o.astype(q.dtype)


def dsa_mixer(q, k, v, q_idx, k_idx, w_idx, rel_bias_dsa):
    f32 = jnp.float32
    B, L, _ = q.shape
    n_sel = min(DSA_TOPK_MAX, L // 4)
    nb = L // Q_BLOCK
    q = q.reshape(B, L, DSA_HEADS, HEAD_DIM) * HEAD_DIM ** -0.5
    q_idx = q_idx.reshape(B, L, IDX_HEADS, IDX_DIM)
    w_idx = w_idx * (IDX_HEADS ** -0.5 * IDX_DIM ** -0.5)

    def blocks(t):
        return jnp.swapaxes(t.reshape((B, nb, Q_BLOCK) + t.shape[2:]), 0, 1)

    key_pos = jnp.arange(L)
    gather = jax.vmap(lambda table, idx: table[idx])

    def block(inp):
        j, qb, qib, wb = inp
        t_pos = j * Q_BLOCK + jnp.arange(Q_BLOCK)
        rel = jax.nn.relu(jnp.einsum('bthd,bsd->bths', qib, k_idx))
        score = jnp.einsum('bth,bths->bts', wb, rel).astype(f32)
        admissible = key_pos[None, :] <= t_pos[:, None]
        score = jnp.where(admissible[None], score, -jnp.inf)
        _, sel = lax.top_k(score, n_sel)
        dist = t_pos[None, :, None] - sel
        valid = dist >= 0
        kg = gather(k, sel)
        vg = gather(v, sel)
        logits = jnp.einsum('bthd,btkd->bhtk', qb, kg).astype(f32)
        bias = jnp.moveaxis(rel_bias_dsa[rel_bucket(dist)], -1, 1)
        logits = jnp.where(valid[:, None], logits + bias, -jnp.inf)
        probs = jax.nn.softmax(logits, axis=-1).astype(vg.dtype)
        return jnp.einsum('bhtk,btkd->bthd', probs, vg)

    out = lax.map(block, (jnp.arange(nb), blocks(q), blocks(q_idx), blocks(w_idx)))
    return jnp.swapaxes(out, 0, 1).reshape(B, L, DSA_HEADS * HEAD_DIM)


def swa_mixer(q, k, v, sinks, rel_bias_swa):
    f32 = jnp.float32
    B, L, _ = q.shape
    nb = L // WINDOW
    qb = q.reshape(B, nb, WINDOW, SWA_KV_HEADS, SWA_GROUP, HEAD_DIM) * HEAD_DIM ** -0.5

    def band(t):
        t = t.reshape(B, nb, WINDOW, SWA_KV_HEADS, HEAD_DIM)
        prev = jnp.pad(t[:, :-1], ((0, 0), (1, 0), (0, 0), (0, 0), (0, 0)))
        return jnp.concatenate([prev, t], axis=2)

    kw, vw = band(k), band(v)
    qi = jnp.arange(WINDOW)[:, None]
    kj = jnp.arange(2 * WINDOW)[None, :]
    dist = qi + WINDOW - kj
    in_window = (dist >= 0) & (dist < WINDOW)
    key_pos = jnp.arange(nb)[:, None, None] * WINDOW - WINDOW + kj[None]
    mask = in_window[None] & (key_pos >= 0)
    bias = jnp.transpose(rel_bias_swa[rel_bucket(dist)], (2, 0, 1)).reshape(
        SWA_KV_HEADS, SWA_GROUP, WINDOW, 2 * WINDOW)
    logits = jnp.einsum('bnqhgd,bnkhd->bnhgqk', qb, kw).astype(f32) + bias.astype(f32)
    logits = jnp.where(mask[None, :, None, None], logits, -jnp.inf)
    sink = sinks.astype(f32).reshape(SWA_KV_HEADS, SWA_GROUP)[None, None, :, :, None, None]
    m = jnp.maximum(jnp.max(logits, axis=-1, keepdims=True), sink)
    e = jnp.exp(logits - m)
    probs = e / (jnp.sum(e, axis=-1, keepdims=True) + jnp.exp(sink - m))
    out = jnp.einsum('bnhgqk,bnkhd->bnqhgd', probs.astype(vw.dtype), vw)
    return out.reshape(B, L, SWA_HEADS * HEAD_DIM)


def hier_moe(x, w_rg, b_rg, w_re, b_re, w_gate, w_up, w_down):
    f32 = jnp.float32
    B, L, D = x.shape
    T = B * L
    xt = x.reshape(T, D)
    g_prob = jax.nn.softmax((xt @ w_rg + b_rg).astype(f32), axis=-1)
    g_w, g_sel = lax.top_k(g_prob, 1)
    e_logits = (xt @ w_re + b_re).astype(f32).reshape(T, N_GROUPS, EXPERTS_PER_GROUP)
    e_logits = jnp.take_along_axis(e_logits, g_sel[:, :, None], axis=1)[:, 0]
    e_w, e_sel = lax.top_k(jax.nn.softmax(e_logits, axis=-1), TOP_K_IN_GROUP)
    gate = g_w * e_w / jnp.sum(e_w, axis=-1, keepdims=True)
    expert = g_sel * EXPERTS_PER_GROUP + e_sel
    flat_e = expert.reshape(-1)
    order = jnp.argsort(flat_e)
    e_sorted = flat_e[order]
    tok = order // TOP_K_IN_GROUP
    counts = jnp.bincount(flat_e, length=N_EXPERTS)
    padded = (counts + EXPERT_BLOCK - 1) // EXPERT_BLOCK * EXPERT_BLOCK
    start = jnp.cumsum(counts) - counts
    pad_end = jnp.cumsum(padded)
    pad_start = pad_end - padded
    rank = jnp.arange(flat_e.shape[0])
    row = pad_start[e_sorted] + rank - start[e_sorted]
    n_blocks = -(-(T * TOP_K_IN_GROUP) // EXPERT_BLOCK) + N_EXPERTS
    buf = jnp.zeros((n_blocks * EXPERT_BLOCK, D), x.dtype).at[row].set(xt[tok])
    blk_expert = jnp.minimum(
        jnp.searchsorted(pad_end, jnp.arange(n_blocks) * EXPERT_BLOCK, side='right'), N_EXPERTS - 1)

    def expert_block(inp):
        xb, e = inp
        hmid = jax.nn.silu(xb @ w_gate[e]) * (xb @ w_up[e])
        return hmid @ w_down[e]

    yb = lax.map(expert_block, (buf.reshape(n_blocks, EXPERT_BLOCK, D), blk_expert))
    y = yb.reshape(-1, D)[row] * gate.reshape(-1)[order][:, None].astype(x.dtype)
    return jnp.zeros((T, D), x.dtype).at[tok].add(y).reshape(B, L, D)


def setup_inputs(seed: int = 0) -> dict:
    key = jax.random.key(seed)
    ks = jax.random.split(key, 24)
    f32 = jnp.float32

    def nrm(k, shape, scale):
        return jax.random.normal(k, shape, f32) * scale

    return {
        'x': nrm(ks[0], (BATCH, SEQ, D_MODEL), 1.0),
        'p': nrm(ks[1], (DEPTH, BATCH, SEQ, PLE_DIM), 1.0),
        'rel_bias': nrm(ks[2], (REL_BUCKETS, BIAS_HEADS), 0.5),
        'g_mix': 1.0 + nrm(ks[3], (DEPTH, D_MODEL), 0.05),
        'w_in': nrm(ks[4], (DEPTH, D_MODEL, D_IN), D_MODEL ** -0.5),
        'gla_w_alpha': nrm(ks[5], (DEPTH, GLA_RANK, GLA_HEADS * GLA_DK), GLA_RANK ** -0.5),
        'gla_b_alpha': nrm(ks[6], (DEPTH, GLA_HEADS * GLA_DK), 0.1),
        'gla_g_norm': 1.0 + nrm(ks[7], (DEPTH, GLA_DV), 0.05),
        'swa_sinks': nrm(ks[8], (DEPTH, SWA_HEADS), 0.5),
        'w_out': nrm(ks[9], (DEPTH, D_MIX, D_MODEL), D_MIX ** -0.5),
        'g_ffn': 1.0 + nrm(ks[10], (DEPTH, D_MODEL), 0.05),
        'w_router_group': nrm(ks[11], (DEPTH, D_MODEL, N_GROUPS), D_MODEL ** -0.5),
        'b_router_group': nrm(ks[12], (DEPTH, N_GROUPS), 0.01),
        'w_router_expert': nrm(ks[13], (DEPTH, D_MODEL, N_EXPERTS), D_MODEL ** -0.5),
        'b_router_expert': nrm(ks[14], (DEPTH, N_EXPERTS), 0.01),
        'w_expert_gate': nrm(ks[15], (DEPTH, N_EXPERTS, D_MODEL, D_EXPERT), D_MODEL ** -0.5),
        'w_expert_up': nrm(ks[16], (DEPTH, N_EXPERTS, D_MODEL, D_EXPERT), D_MODEL ** -0.5),
        'w_expert_down': nrm(ks[17], (DEPTH, N_EXPERTS, D_EXPERT, D_MODEL), D_EXPERT ** -0.5),
        'w_ple': nrm(ks[18], (DEPTH, PLE_DIM, D_MODEL), PLE_DIM ** -0.5),
        'g_ple': 1.0 + nrm(ks[19], (DEPTH, D_MODEL), 0.05),
        'w_ple_gate': nrm(ks[20], (DEPTH, D_MODEL, D_MODEL), D_MODEL ** -0.5),
        'g_final': 1.0 + nrm(ks[21], (D_MODEL,), 0.05),
    }


def reference(x, p, rel_bias, g_mix, w_in, gla_w_alpha, gla_b_alpha, gla_g_norm, swa_sinks,
              w_out, g_ffn, w_router_group, b_router_group, w_router_expert, b_router_expert,
              w_expert_gate, w_expert_up, w_expert_down, w_ple, g_ple, w_ple_gate, g_final):
    splits = np.cumsum(IN_SPLITS)[:-1].tolist()
    bias_dsa = rel_bias[:, :DSA_HEADS]
    bias_swa = rel_bias[:, DSA_HEADS:]
    h = x
    for i in range(DEPTH):
        a = rms_norm(h, g_mix[i])
        (gq, gk, gv, gg, ga, dq, dk, dv, iq, ik, iw, sq, sk, sv) = jnp.split(a @ w_in[i], splits, axis=-1)
        o = jnp.concatenate([
            gla_mixer(gq, gk, gv, gg, ga, gla_w_alpha[i], gla_b_alpha[i], gla_g_norm[i]),
            dsa_mixer(dq, dk, dv, iq, ik, iw, bias_dsa),
            swa_mixer(sq, sk, sv, swa_sinks[i], bias_swa),
        ], axis=-1)
        h = h + o @ w_out[i]
        h = h + hier_moe(rms_norm(h, g_ffn[i]), w_router_group[i], b_router_group[i],
                         w_router_expert[i], b_router_expert[i],
                         w_expert_gate[i], w_expert_up[i], w_expert_down[i])
        e = rms_norm(p[i] @ w_ple[i], g_ple[i])
        h = h + e * jax.nn.sigmoid(h @ w_ple_gate[i])
    return rms_norm(h, g_final)
```

```cpp
#include <hip/hip_runtime.h>
#include <stdint.h>

#define T_TOK 16384
#define SEQ 2048
#define NBATCH 8
#define DM 1024
#define DIN 2520
#define PLE_D 256
#define NEXP 32
#define DEXP 512
#define MOE_BLK 64
#define MOE_NBLK (T_TOK * 2 / MOE_BLK + NEXP)
#define MOE_ROWS (MOE_NBLK * MOE_BLK)
#define C_GQ 0
#define C_GK 128
#define C_GV 256
#define C_GG 512
#define C_GA 768
#define C_DQ 784
#define C_DK 1040
#define C_DV 1104
#define C_IQ 1168
#define C_IK 1680
#define C_IW 1744
#define C_SQ 1752
#define C_SK 2264
#define C_SV 2392
#define EPS 1e-6f

__device__ __forceinline__ int rel_bucket(int n) {
    if (n < 16) return n;
    const float nf = (float)n;
    int large = 16 + (int)(logf(nf / 16.0f) / 2.0794415416798357f * 16.0f);
    return large < 31 ? large : 31;
}
__device__ __forceinline__ float wave_sum(float v) {
#pragma unroll
    for (int o = 32; o > 0; o >>= 1) v += __shfl_xor(v, o);
    return v;
}
__device__ __forceinline__ float wave_max(float v) {
#pragma unroll
    for (int o = 32; o > 0; o >>= 1) v = fmaxf(v, __shfl_xor(v, o));
    return v;
}
__device__ __forceinline__ float sigmoidf_(float x) { return 1.0f / (1.0f + expf(-x)); }
__device__ __forceinline__ float siluf_(float x) { return x / (1.0f + expf(-x)); }

__global__ __launch_bounds__(256) void rmsnorm_k(const float* X, const float* __restrict__ g, float* Y, int rows) {
    const int row = blockIdx.x * 4 + (threadIdx.x >> 6), lane = threadIdx.x & 63;
    if (row >= rows) return;
    const float4* x4 = (const float4*)(X + (size_t)row * DM);
    float4 v[4]; float ss = 0.f;
#pragma unroll
    for (int i = 0; i < 4; ++i) { v[i] = x4[lane + 64 * i]; ss += v[i].x * v[i].x + v[i].y * v[i].y + v[i].z * v[i].z + v[i].w * v[i].w; }
    ss = wave_sum(ss);
    const float r = rsqrtf(ss * (1.0f / DM) + EPS);
    float4* y4 = (float4*)(Y + (size_t)row * DM);
    const float4* g4 = (const float4*)g;
#pragma unroll
    for (int i = 0; i < 4; ++i) { const float4 gg = g4[lane + 64 * i]; float4 o; o.x = v[i].x * r * gg.x; o.y = v[i].y * r * gg.y; o.z = v[i].z * r * gg.z; o.w = v[i].w * r * gg.w; y4[lane + 64 * i] = o; }
}

struct GemmP {
    const float* A; int lda; const int* arow;
    const float* B; const float* B2; int ldb; long long strideB; const int* blk_e;
    float* C; int ldc; int M, N, K;
    const float* R; const float* E;
};
template <int EPI> __global__ __launch_bounds__(256) void sgemm_k(GemmP p) {
    __shared__ float As[16][68];
    __shared__ float Bs[16][64];
    __shared__ float Bs2[(EPI == 2) ? 16 : 1][64];
    const int tid = threadIdx.x, tx = tid & 15, ty = tid >> 4;
    const int bm = blockIdx.y * 64, bn = blockIdx.x * 64;
    const size_t boff = p.blk_e ? (size_t)p.blk_e[blockIdx.y] * (size_t)p.strideB : 0;
    const float* B = p.B + boff; const float* B2 = (EPI == 2) ? p.B2 + boff : p.B;
    const int ar = tid >> 2, ak = (tid & 3) * 4;
    int arow = bm + ar; if (p.arow) arow = p.arow[bm + ar];
    const float* Ap = arow >= 0 ? p.A + (size_t)arow * p.lda + ak : nullptr;
    const int bk = tid >> 4, bnn = (tid & 15) * 4;
    const bool bok = (bn + bnn) < p.N;
    float acc[4][4], acc2[4][4];
#pragma unroll
    for (int i = 0; i < 4; ++i)
#pragma unroll
        for (int j = 0; j < 4; ++j) { acc[i][j] = 0.f; acc2[i][j] = 0.f; }
    for (int k0 = 0; k0 < p.K; k0 += 16) {
        float4 a = make_float4(0.f, 0.f, 0.f, 0.f), b = a, b2 = a;
        if (Ap) a = *(const float4*)(Ap + k0);
        if (bok) b = *(const float4*)(B + (size_t)(k0 + bk) * p.ldb + bn + bnn);
        if (EPI == 2) { if (bok) b2 = *(const float4*)(B2 + (size_t)(k0 + bk) * p.ldb + bn + bnn); }
        __syncthreads();
        As[ak + 0][ar] = a.x; As[ak + 1][ar] = a.y; As[ak + 2][ar] = a.z; As[ak + 3][ar] = a.w;
        *(float4*)&Bs[bk][bnn] = b;
        if (EPI == 2) *(float4*)&Bs2[bk][bnn] = b2;
        __syncthreads();
#pragma unroll
        for (int k = 0; k < 16; ++k) {
            const float4 av = *(const float4*)&As[k][ty * 4];
            const float4 bv = *(const float4*)&Bs[k][tx * 4];
#define FMA4(ACC, i, a_, b4) ACC[i][0] += a_ * b4.x; ACC[i][1] += a_ * b4.y; ACC[i][2] += a_ * b4.z; ACC[i][3] += a_ * b4.w;
            FMA4(acc, 0, av.x, bv) FMA4(acc, 1, av.y, bv) FMA4(acc, 2, av.z, bv) FMA4(acc, 3, av.w, bv)
            if (EPI == 2) {
                const float4 cv = *(const float4*)&Bs2[k][tx * 4];
                FMA4(acc2, 0, av.x, cv) FMA4(acc2, 1, av.y, cv) FMA4(acc2, 2, av.z, cv) FMA4(acc2, 3, av.w, cv)
            }
#undef FMA4
        }
    }
    const int col = bn + tx * 4;
    if (col >= p.N) return;
#pragma unroll
    for (int i = 0; i < 4; ++i) {
        const size_t o = (size_t)(bm + ty * 4 + i) * p.ldc + col;
        float4 r;
        if (EPI == 0) r = make_float4(acc[i][0], acc[i][1], acc[i][2], acc[i][3]);
        if (EPI == 1) { const float4 rr = *(const float4*)(p.R + o); r = make_float4(rr.x + acc[i][0], rr.y + acc[i][1], rr.z + acc[i][2], rr.w + acc[i][3]); }
        if (EPI == 2) r = make_float4(siluf_(acc[i][0]) * acc2[i][0], siluf_(acc[i][1]) * acc2[i][1], siluf_(acc[i][2]) * acc2[i][2], siluf_(acc[i][3]) * acc2[i][3]);
        if (EPI == 3) { const float4 rr = *(const float4*)(p.R + o); const float4 ee = *(const float4*)(p.E + o);
            r = make_float4(rr.x + ee.x * sigmoidf_(acc[i][0]), rr.y + ee.y * sigmoidf_(acc[i][1]), rr.z + ee.z * sigmoidf_(acc[i][2]), rr.w + ee.w * sigmoidf_(acc[i][3])); }
        *(float4*)(p.C + o) = r;
    }
}

__global__ __launch_bounds__(128) void gla_alpha_k(const float* __restrict__ P, const float* __restrict__ wa, const float* __restrict__ ba, float* __restrict__ ALPHA) {
    const int t = blockIdx.x, j = threadIdx.x;
    const float* ga = P + (size_t)t * DIN + C_GA;
    float x = 0.f;
#pragma unroll
    for (int r = 0; r < 16; ++r) x += ga[r] * wa[r * 128 + j];
    x += ba[j];
    const float ls = fminf(x, 0.f) - log1pf(expf(-fabsf(x)));
    ALPHA[(size_t)t * 128 + j] = expf(ls * (1.0f / 16.0f));
}
__global__ __launch_bounds__(256) void gla_naive_k(const float* __restrict__ P, const float* __restrict__ ALPHA, const float* __restrict__ gnorm, float* __restrict__ O) {
    const int b = blockIdx.x >> 2, h = blockIdx.x & 3;
    const int tid = threadIdx.x, v = tid & 63, kg = tid >> 6;
    __shared__ float part[2][4][64];
    __shared__ float sq[32], sk[32], sa[32];
    float S[8];
#pragma unroll
    for (int i = 0; i < 8; ++i) S[i] = 0.f;
    const float gn = gnorm[v];
    for (int t = 0; t < SEQ; ++t) {
        const size_t row = (size_t)(b * SEQ + t);
        const float* pr = P + row * DIN;
        if (tid < 32) sq[tid] = pr[C_GQ + h * 32 + tid] * 0.17677669529663687f;
        else if (tid < 64) sk[tid - 32] = pr[C_GK + h * 32 + tid - 32];
        else if (tid < 96) sa[tid - 64] = ALPHA[row * 128 + h * 32 + tid - 64];
        const float vv = pr[C_GV + h * 64 + v];
        __syncthreads();
        float o = 0.f;
#pragma unroll
        for (int i = 0; i < 8; ++i) { const int k = kg * 8 + i; S[i] = sa[k] * S[i] + sk[k] * vv; o += sq[k] * S[i]; }
        part[t & 1][kg][v] = o;
        __syncthreads();
        if (tid < 64) {
            float ot = part[t & 1][0][v] + part[t & 1][1][v] + part[t & 1][2][v] + part[t & 1][3][v];
            const float ms = wave_sum(ot * ot) * (1.0f / 64.0f);
            ot = ot * rsqrtf(ms + EPS) * gn;
            const float g = pr[C_GG + h * 64 + v];
            O[row * DM + h * 64 + v] = ot * siluf_(g);
        }
    }
}

__device__ __forceinline__ int block_sum_i(int v, int* red) {
#pragma unroll
    for (int o = 32; o > 0; o >>= 1) v += __shfl_xor(v, o);
    __syncthreads();
    if ((threadIdx.x & 63) == 0) red[threadIdx.x >> 6] = v;
    __syncthreads();
    return red[0] + red[1] + red[2] + red[3];
}
__global__ __launch_bounds__(256) void dsa_naive_k(const float* __restrict__ P, const float* __restrict__ rel_bias, float* __restrict__ O) {
    const int tg = blockIdx.x, b = tg / SEQ, t = tg % SEQ, tid = threadIdx.x;
    __shared__ float qi[512];
    __shared__ float wq[8];
    __shared__ float qd[256];
    __shared__ float lg[4 * 2048];
    __shared__ int red[4];
    __shared__ float redf[4][8];
    const float* pr = P + (size_t)tg * DIN;
    qi[tid] = pr[C_IQ + tid]; qi[tid + 256] = pr[C_IQ + 256 + tid];
    qd[tid] = pr[C_DQ + tid] * 0.125f;
    if (tid < 8) wq[tid] = pr[C_IW + tid] * 0.04419417382415922f;
    __syncthreads();
    unsigned keys[8];
#pragma unroll
    for (int i = 0; i < 8; ++i) {
        const int s = tid + 256 * i;
        keys[i] = 0u;
        if (s <= t) {
            const float* kr = P + (size_t)(b * SEQ + s) * DIN + C_IK;
            float acc[8];
#pragma unroll
            for (int h = 0; h < 8; ++h) acc[h] = 0.f;
            for (int d = 0; d < 64; d += 4) {
                const float4 kv = *(const float4*)(kr + d);
#pragma unroll
                for (int h = 0; h < 8; ++h) acc[h] += qi[h * 64 + d] * kv.x + qi[h * 64 + d + 1] * kv.y + qi[h * 64 + d + 2] * kv.z + qi[h * 64 + d + 3] * kv.w;
            }
            float sc = 0.f;
#pragma unroll
            for (int h = 0; h < 8; ++h) sc += wq[h] * fmaxf(acc[h], 0.f);
            sc += 0.0f;
            const unsigned u = __float_as_uint(sc);
            keys[i] = (u & 0x80000000u) ? ~u : (u | 0x80000000u);
        }
    }
    unsigned K = 0u; int cut = SEQ;
    if (t + 1 > 256) {
        for (int bit = 31; bit >= 0; --bit) {
            const unsigned cand = K | (1u << bit);
            int c = 0;
#pragma unroll
            for (int i = 0; i < 8; ++i) c += (keys[i] >= cand) ? 1 : 0;
            if (block_sum_i(c, red) >= 256) K = cand;
        }
        int cg = 0, ce = 0;
#pragma unroll
        for (int i = 0; i < 8; ++i) { cg += (keys[i] > K) ? 1 : 0; ce += (keys[i] == K) ? 1 : 0; }
        const int ngt = block_sum_i(cg, red), neq = block_sum_i(ce, red);
        const int r = 256 - ngt;
        if (neq > r) {
            int lo = 0, hi = SEQ - 1;
            while (lo < hi) {
                const int mid = (lo + hi) >> 1;
                int c = 0;
#pragma unroll
                for (int i = 0; i < 8; ++i) c += (keys[i] == K && (tid + 256 * i) <= mid) ? 1 : 0;
                if (block_sum_i(c, red) >= r) hi = mid; else lo = mid + 1;
            }
            cut = lo;
        }
    }
    float mx[4] = {-INFINITY, -INFINITY, -INFINITY, -INFINITY};
#pragma unroll
    for (int i = 0; i < 8; ++i) {
        const int s = tid + 256 * i;
        const bool sel = (s <= t) && (keys[i] > K || (keys[i] == K && s <= cut));
        float l[4] = {-INFINITY, -INFINITY, -INFINITY, -INFINITY};
        if (sel) {
            const float* kr = P + (size_t)(b * SEQ + s) * DIN + C_DK;
            float acc[4] = {0.f, 0.f, 0.f, 0.f};
            for (int d = 0; d < 64; d += 4) {
                const float4 kv = *(const float4*)(kr + d);
#pragma unroll
                for (int h = 0; h < 4; ++h) acc[h] += qd[h * 64 + d] * kv.x + qd[h * 64 + d + 1] * kv.y + qd[h * 64 + d + 2] * kv.z + qd[h * 64 + d + 3] * kv.w;
            }
            const int bk = rel_bucket(t - s);
#pragma unroll
            for (int h = 0; h < 4; ++h) { l[h] = acc[h] + rel_bias[bk * 12 + h]; mx[h] = fmaxf(mx[h], l[h]); }
        }
#pragma unroll
        for (int h = 0; h < 4; ++h) lg[h * 2048 + s] = l[h];
    }
#pragma unroll
    for (int h = 0; h < 4; ++h) mx[h] = wave_max(mx[h]);
    if ((tid & 63) == 0) { for (int h = 0; h < 4; ++h) redf[tid >> 6][h] = mx[h]; }
    __syncthreads();
    float sm[4] = {0.f, 0.f, 0.f, 0.f};
#pragma unroll
    for (int h = 0; h < 4; ++h) mx[h] = fmaxf(fmaxf(redf[0][h], redf[1][h]), fmaxf(redf[2][h], redf[3][h]));
#pragma unroll
    for (int i = 0; i < 8; ++i) {
        const int s = tid + 256 * i;
#pragma unroll
        for (int h = 0; h < 4; ++h) { const float l = lg[h * 2048 + s]; const float e = (l == -INFINITY) ? 0.f : expf(l - mx[h]); lg[h * 2048 + s] = e; sm[h] += e; }
    }
#pragma unroll
    for (int h = 0; h < 4; ++h) sm[h] = wave_sum(sm[h]);
    if ((tid & 63) == 0) { for (int h = 0; h < 4; ++h) redf[tid >> 6][4 + h] = sm[h]; }
    __syncthreads();
    {
        const int h = tid >> 6, d = tid & 63;
        const float den = redf[0][4 + h] + redf[1][4 + h] + redf[2][4 + h] + redf[3][4 + h];
        float acc = 0.f;
        const float* vb = P + (size_t)(b * SEQ) * DIN + C_DV + d;
        for (int s = 0; s <= t; ++s) {
            const float pv = lg[h * 2048 + s];
            if (pv != 0.f) acc += pv * vb[(size_t)s * DIN];
        }
        O[(size_t)tg * DM + 256 + h * 64 + d] = acc / den;
    }
}

__global__ __launch_bounds__(256) void swa_naive_k(const float* __restrict__ P, const float* __restrict__ rel_bias, const float* __restrict__ sinks, float* __restrict__ O) {
    const int tg = blockIdx.x, b = tg / SEQ, t = tg % SEQ, tid = threadIdx.x;
    __shared__ float q[512];
    __shared__ float lg[8 * 128];
    const float* pr = P + (size_t)tg * DIN;
    q[tid] = pr[C_SQ + tid] * 0.125f; q[tid + 256] = pr[C_SQ + 256 + tid] * 0.125f;
    __syncthreads();
#pragma unroll
    for (int i = 0; i < 4; ++i) {
        const int idx = tid + 256 * i, h = idx >> 7, j = idx & 127, s = t - 127 + j;
        float l = -INFINITY;
        if (s >= 0) {
            const float* kr = P + (size_t)(b * SEQ + s) * DIN + C_SK + (h >> 2) * 64;
            float acc = 0.f;
            for (int d = 0; d < 64; d += 4) { const float4 kv = *(const float4*)(kr + d); acc += q[h * 64 + d] * kv.x + q[h * 64 + d + 1] * kv.y + q[h * 64 + d + 2] * kv.z + q[h * 64 + d + 3] * kv.w; }
            l = acc + rel_bias[rel_bucket(127 - j) * 12 + 4 + h];
        }
        lg[idx] = l;
    }
    __syncthreads();
    {
        const int w = tid >> 6, lane = tid & 63;
#pragma unroll
        for (int hh = 0; hh < 2; ++hh) {
            const int h = w * 2 + hh;
            const float l0 = lg[h * 128 + lane], l1 = lg[h * 128 + 64 + lane];
            const float sk = sinks[h];
            const float m = fmaxf(wave_max(fmaxf(l0, l1)), sk);
            const float e0 = expf(l0 - m), e1 = expf(l1 - m);
            const float den = wave_sum(e0 + e1) + expf(sk - m);
            lg[h * 128 + lane] = e0 / den; lg[h * 128 + 64 + lane] = e1 / den;
        }
    }
    __syncthreads();
#pragma unroll
    for (int i = 0; i < 2; ++i) {
        const int idx = tid + 256 * i, h = idx >> 6, d = idx & 63;
        float acc = 0.f;
        for (int j = 0; j < 128; ++j) {
            const int s = t - 127 + j;
            if (s >= 0) acc += lg[h * 128 + j] * P[(size_t)(b * SEQ + s) * DIN + C_SV + (h >> 2) * 64 + d];
        }
        O[(size_t)tg * DM + 512 + h * 64 + d] = acc;
    }
}

__global__ __launch_bounds__(256) void route_k(const float* __restrict__ XN, const float* __restrict__ wrg, const float* __restrict__ brg, const float* __restrict__ wre, const float* __restrict__ bre,
                                               int* __restrict__ expert, float* __restrict__ gate, int* __restrict__ counts) {
    const int w = threadIdx.x >> 6, lane = threadIdx.x & 63, t = blockIdx.x * 4 + w;
    __shared__ float lgs[4][36];
    float acc[36];
#pragma unroll
    for (int j = 0; j < 36; ++j) acc[j] = 0.f;
    for (int k = lane; k < DM; k += 64) {
        const float x = XN[(size_t)t * DM + k];
        const float4 g4 = *(const float4*)(wrg + k * 4);
        acc[0] += x * g4.x; acc[1] += x * g4.y; acc[2] += x * g4.z; acc[3] += x * g4.w;
#pragma unroll
        for (int j = 0; j < 32; j += 4) { const float4 e4 = *(const float4*)(wre + k * 32 + j); acc[4 + j] += x * e4.x; acc[5 + j] += x * e4.y; acc[6 + j] += x * e4.z; acc[7 + j] += x * e4.w; }
    }
#pragma unroll
    for (int j = 0; j < 36; ++j) { const float s = wave_sum(acc[j]); if (lane == 0) lgs[w][j] = s; }
    __syncthreads();
    if (lane == 0) {
        float gl[4], m = -INFINITY;
        for (int j = 0; j < 4; ++j) { gl[j] = lgs[w][j] + brg[j]; m = fmaxf(m, gl[j]); }
        float sum = 0.f; for (int j = 0; j < 4; ++j) { gl[j] = expf(gl[j] - m); sum += gl[j]; }
        int gs = 0; float gw = gl[0] / sum;
        for (int j = 1; j < 4; ++j) { const float pj = gl[j] / sum; if (pj > gw) { gw = pj; gs = j; } }
        float el[8]; m = -INFINITY;
        for (int j = 0; j < 8; ++j) { el[j] = lgs[w][4 + gs * 8 + j] + bre[gs * 8 + j]; m = fmaxf(m, el[j]); }
        sum = 0.f; for (int j = 0; j < 8; ++j) { el[j] = expf(el[j] - m); sum += el[j]; }
        for (int j = 0; j < 8; ++j) el[j] = el[j] / sum;
        int i1 = 0; for (int j = 1; j < 8; ++j) if (el[j] > el[i1]) i1 = j;
        int i2 = (i1 == 0) ? 1 : 0; for (int j = 0; j < 8; ++j) if (j != i1 && el[j] > el[i2]) i2 = j;
        const float es = el[i1] + el[i2];
        const int e1 = gs * 8 + i1, e2 = gs * 8 + i2;
        expert[2 * t] = e1; expert[2 * t + 1] = e2;
        gate[2 * t] = gw * el[i1] / es; gate[2 * t + 1] = gw * el[i2] / es;
        atomicAdd(&counts[e1], 1); atomicAdd(&counts[e2], 1);
    }
}
__global__ void moe_scan_k(const int* __restrict__ counts, int* __restrict__ cursor, int* __restrict__ blk_e) {
    __shared__ int pend[NEXP];
    if (threadIdx.x == 0) {
        int run = 0;
        for (int e = 0; e < NEXP; ++e) { cursor[e] = run; run += (counts[e] + MOE_BLK - 1) / MOE_BLK * MOE_BLK; pend[e] = run; }
    }
    __syncthreads();
    for (int blk = threadIdx.x; blk < MOE_NBLK; blk += blockDim.x) {
        int c = 0;
        for (int e = 0; e < NEXP; ++e) c += (pend[e] <= blk * MOE_BLK) ? 1 : 0;
        blk_e[blk] = c < NEXP - 1 ? c : NEXP - 1;
    }
}
__global__ __launch_bounds__(256) void moe_assign_k(const int* __restrict__ expert, int* __restrict__ cursor, int* __restrict__ rowtok, int* __restrict__ slotrow) {
    const int slot = blockIdx.x * 256 + threadIdx.x;
    const int e = expert[slot];
    const int r = atomicAdd(&cursor[e], 1);
    rowtok[r] = slot >> 1; slotrow[slot] = r;
}
__global__ __launch_bounds__(256) void moe_combine_k(float* __restrict__ H, const float* __restrict__ Y, const int* __restrict__ slotrow, const float* __restrict__ gate) {
    const int t = blockIdx.x, c = threadIdx.x * 4;
    const int r0 = slotrow[2 * t], r1 = slotrow[2 * t + 1];
    const float g0 = gate[2 * t], g1 = gate[2 * t + 1];
    const float4 y0 = *(const float4*)(Y + (size_t)r0 * DM + c), y1 = *(const float4*)(Y + (size_t)r1 * DM + c);
    float4 h = *(float4*)(H + (size_t)t * DM + c);
    h.x += y0.x * g0 + y1.x * g1; h.y += y0.y * g0 + y1.y * g1; h.z += y0.z * g0 + y1.z * g1; h.w += y0.w * g0 + y1.w * g1;
    *(float4*)(H + (size_t)t * DM + c) = h;
}

template <int EPI> static void launch_gemm(const GemmP& p, hipStream_t st) {
    dim3 grid((p.N + 63) / 64, p.M / 64);
    hipLaunchKernelGGL(sgemm_k<EPI>, grid, dim3(256), 0, st, p);
}

extern "C" void kernel_launch(void* const* d_in, const int* in_sizes, int n_in, void* d_out, int out_size, void* d_ws, size_t ws_size, hipStream_t stream) {
    const float* x = (const float*)d_in[0];
    const float* pl = (const float*)d_in[1];
    const float* rel_bias = (const float*)d_in[2];
    const float* g_mix = (const float*)d_in[3];
    const float* w_in = (const float*)d_in[4];
    const float* gla_wa = (const float*)d_in[5];
    const float* gla_ba = (const float*)d_in[6];
    const float* gla_gn = (const float*)d_in[7];
    const float* sinks = (const float*)d_in[8];
    const float* w_out = (const float*)d_in[9];
    const float* g_ffn = (const float*)d_in[10];
    const float* w_rg = (const float*)d_in[11];
    const float* b_rg = (const float*)d_in[12];
    const float* w_re = (const float*)d_in[13];
    const float* b_re = (const float*)d_in[14];
    const float* w_eg = (const float*)d_in[15];
    const float* w_eu = (const float*)d_in[16];
    const float* w_ed = (const float*)d_in[17];
    const float* w_ple = (const float*)d_in[18];
    const float* g_ple = (const float*)d_in[19];
    const float* w_pg = (const float*)d_in[20];
    const float* g_final = (const float*)d_in[21];
    float* out = (float*)d_out;

    const size_t nH = (size_t)T_TOK * DM;
    float* ws = (float*)d_ws;
    size_t off = 0;
    float* HA = ws + off; off += nH;
    float* HB = ws + off; off += nH;
    float* AX = ws + off; off += nH;
    float* PY = ws + off; off += (size_t)T_TOK * DIN;
    float* OE = ws + off; off += nH;
    float* HM = ws + off; off += (size_t)MOE_ROWS * DEXP;
    int* ibase = (int*)(ws + off);
    int* counts = ibase;
    int* cursor = ibase + 64;
    int* blk_e = ibase + 128;
    int* expert = ibase + 1024;
    int* slotrow = expert + 2 * T_TOK;
    int* rowtok = slotrow + 2 * T_TOK;
    float* gate = (float*)(rowtok + MOE_ROWS);
    off += 1024 + 4 * T_TOK + MOE_ROWS + 2 * T_TOK + 64;
    if (off * sizeof(float) > ws_size) return;
    float* ALPHA = HM;

    const float* hcur = x;
    float* hbuf[2] = {HA, HB};
    int hsel = 0;
    for (int L = 0; L < 2; ++L) {
        hipLaunchKernelGGL(rmsnorm_k, dim3(T_TOK / 4), dim3(256), 0, stream, hcur, g_mix + L * DM, AX, T_TOK);
        { GemmP p{}; p.A = AX; p.lda = DM; p.B = w_in + (size_t)L * DM * DIN; p.ldb = DIN; p.C = PY; p.ldc = DIN; p.M = T_TOK; p.N = DIN; p.K = DM; launch_gemm<0>(p, stream); }
        hipLaunchKernelGGL(gla_alpha_k, dim3(T_TOK), dim3(128), 0, stream, PY, gla_wa + L * 16 * 128, gla_ba + L * 128, ALPHA);
        hipLaunchKernelGGL(gla_naive_k, dim3(32), dim3(256), 0, stream, PY, ALPHA, gla_gn + L * 64, OE);
        hipLaunchKernelGGL(dsa_naive_k, dim3(T_TOK), dim3(256), 0, stream, PY, rel_bias, OE);
        hipLaunchKernelGGL(swa_naive_k, dim3(T_TOK), dim3(256), 0, stream, PY, rel_bias, sinks + L * 8, OE);
        float* hn = hbuf[hsel];
        { GemmP p{}; p.A = OE; p.lda = DM; p.B = w_out + (size_t)L * DM * DM; p.ldb = DM; p.C = hn; p.ldc = DM; p.M = T_TOK; p.N = DM; p.K = DM; p.R = hcur; launch_gemm<1>(p, stream); }
        hipLaunchKernelGGL(rmsnorm_k, dim3(T_TOK / 4), dim3(256), 0, stream, hn, g_ffn + L * DM, AX, T_TOK);
        hipMemsetAsync(counts, 0, 64 * sizeof(int), stream);
        hipMemsetAsync(rowtok, 0xFF, MOE_ROWS * sizeof(int), stream);
        hipLaunchKernelGGL(route_k, dim3(T_TOK / 4), dim3(256), 0, stream, AX, w_rg + L * DM * 4, b_rg + L * 4, w_re + L * DM * 32, b_re + L * 32, expert, gate, counts);
        hipLaunchKernelGGL(moe_scan_k, dim3(1), dim3(256), 0, stream, counts, cursor, blk_e);
        hipLaunchKernelGGL(moe_assign_k, dim3(2 * T_TOK / 256), dim3(256), 0, stream, expert, cursor, rowtok, slotrow);
        { GemmP p{}; p.A = AX; p.lda = DM; p.arow = rowtok; p.B = w_eg + (size_t)L * NEXP * DM * DEXP; p.B2 = w_eu + (size_t)L * NEXP * DM * DEXP; p.ldb = DEXP; p.strideB = (long long)DM * DEXP; p.blk_e = blk_e;
          p.C = HM; p.ldc = DEXP; p.M = MOE_ROWS; p.N = DEXP; p.K = DM; launch_gemm<2>(p, stream); }
        { GemmP p{}; p.A = HM; p.lda = DEXP; p.B = w_ed + (size_t)L * NEXP * DEXP * DM; p.ldb = DM; p.strideB = (long long)DEXP * DM; p.blk_e = blk_e;
          p.C = PY; p.ldc = DM; p.M = MOE_ROWS; p.N = DM; p.K = DEXP; launch_gemm<0>(p, stream); }
        hipLaunchKernelGGL(moe_combine_k, dim3(T_TOK), dim3(256), 0, stream, hn, PY, slotrow, gate);
        { GemmP p{}; p.A = pl + (size_t)L * T_TOK * PLE_D; p.lda = PLE_D; p.B = w_ple + (size_t)L * PLE_D * DM; p.ldb = DM; p.C = OE; p.ldc = DM; p.M = T_TOK; p.N = DM; p.K = PLE_D; launch_gemm<0>(p, stream); }
        hipLaunchKernelGGL(rmsnorm_k, dim3(T_TOK / 4), dim3(256), 0, stream, OE, g_ple + L * DM, OE, T_TOK);
        float* hn2 = hbuf[hsel ^ 1];
        { GemmP p{}; p.A = hn; p.lda = DM; p.B = w_pg + (size_t)L * DM * DM; p.ldb = DM; p.C = hn2; p.ldc = DM; p.M = T_TOK; p.N = DM; p.K = DM; p.R = hn; p.E = OE; launch_gemm<3>(p, stream); }
        hcur = hn2;
    }
    hipLaunchKernelGGL(rmsnorm_k, dim3(T_TOK / 4), dim3(256), 0, stream, hcur, g_final, out, T_TOK);
}
```

```cpp
#include <hip/hip_runtime.h>
#include <stdint.h>

#ifndef MK_PER_PHASE
#define MK_PER_PHASE 0
#endif

#define LAS __attribute__((address_space(3)))
typedef unsigned short bf16_t;
typedef short bf16x8 __attribute__((ext_vector_type(8)));
typedef float f32x4 __attribute__((ext_vector_type(4)));
typedef float f32x2 __attribute__((ext_vector_type(2)));
typedef unsigned u32x4 __attribute__((ext_vector_type(4)));
typedef unsigned u32x2 __attribute__((ext_vector_type(2)));

#define T_TOK 16384
#define SEQ 2048
#define DM 1024
#define DIN 2520
#define DINP 2560
#define PLE_D 256
#define NEXP 32
#define DEXP 512
#define LIST_CAP 32768
#define MOE_PROWS 40960
#define C_GQ 0
#define C_GK 128
#define C_GV 256
#define C_GG 512
#define C_GA 768
#define C_DQ 784
#define C_DK 1040
#define C_DV 1104
#define C_IQ 1168
#define C_IK 1680
#define C_IW 1744
#define C_SQ 1752
#define C_SK 2264
#define C_SV 2392
#define EPS 1e-6f
#define NTHREADS 512
#define LDS_BYTES 159744
#define MISC_OFF 147456

constexpr size_t WS_CTL = 0;
constexpr size_t CTL_BYTES = 32768;
constexpr size_t WS_WIN = WS_CTL + CTL_BYTES;
constexpr size_t SZ_WIN = (size_t)DINP * DM * 2;
constexpr size_t WS_WOUT = WS_WIN + 2 * SZ_WIN;
constexpr size_t SZ_WOUT = (size_t)DM * DM * 2;
constexpr size_t WS_WGU = WS_WOUT + 2 * SZ_WOUT;
constexpr size_t SZ_WGU = (size_t)NEXP * 1024 * DM * 2;
constexpr size_t WS_WD = WS_WGU + 2 * SZ_WGU;
constexpr size_t SZ_WD = (size_t)NEXP * DM * DEXP * 2;
constexpr size_t WS_WPLE = WS_WD + 2 * SZ_WD;
constexpr size_t SZ_WPLE = (size_t)DM * PLE_D * 2;
constexpr size_t WS_WPG = WS_WPLE + 2 * SZ_WPLE;
constexpr size_t SZ_WPG = (size_t)DM * DM * 2;
constexpr size_t WS_PBF = WS_WPG + 2 * SZ_WPG;
constexpr size_t SZ_PBF = (size_t)T_TOK * PLE_D * 2;
constexpr size_t WS_H = WS_PBF + 2 * SZ_PBF;
constexpr size_t WS_ABF = WS_H + (size_t)T_TOK * DM * 4;
constexpr size_t WS_P = WS_ABF + (size_t)T_TOK * DM * 2;
constexpr size_t WS_OMIX = WS_P + (size_t)T_TOK * DINP * 2;
constexpr size_t WS_HMID = WS_OMIX + (size_t)T_TOK * DM * 2;
constexpr size_t WS_EPRE = WS_OMIX;
constexpr size_t WS_GU = WS_HMID + (size_t)MOE_PROWS * DEXP * 2;
constexpr size_t WS_GD = WS_GU + (size_t)256 * 4 * 2048 * 4;
constexpr size_t WS_LIST = WS_GD + (size_t)256 * 128 * 4;
constexpr size_t WS_SLOT = WS_LIST + (size_t)NEXP * LIST_CAP * 4;
constexpr size_t WS_GATE = WS_SLOT + (size_t)T_TOK * 2 * 4;
constexpr size_t WS_ERSTD = WS_GATE + (size_t)T_TOK * 2 * 4;
constexpr size_t WS_END = WS_ERSTD + (size_t)T_TOK * 4;
#define CW_BAR 0
#define CW_CURSOR 4096

__device__ __forceinline__ float bf2f(unsigned b) { return __uint_as_float(b << 16); }
__device__ __forceinline__ unsigned pk2(float lo, float hi) { unsigned r; asm("v_cvt_pk_bf16_f32 %0, %1, %2" : "=v"(r) : "v"(lo), "v"(hi)); return r; }
__device__ __forceinline__ float blo(unsigned w) { return __uint_as_float(w << 16); }
__device__ __forceinline__ float bhi(unsigned w) { return __uint_as_float(w & 0xffff0000u); }
__device__ __forceinline__ float wave_sum(float v) {
#pragma unroll
    for (int o = 32; o > 0; o >>= 1) v += __shfl_xor(v, o);
    return v;
}
__device__ __forceinline__ float wave_max(float v) {
#pragma unroll
    for (int o = 32; o > 0; o >>= 1) v = fmaxf(v, __shfl_xor(v, o));
    return v;
}
__device__ __forceinline__ float fast_sigmoid(float x) { return __builtin_amdgcn_rcpf(1.0f + __expf(-x)); }
__device__ __forceinline__ int rel_bucket(int n) {
    if (n < 16) return n;
    const float nf = (float)n;
    int large = 16 + (int)(logf(nf / 16.0f) / 2.0794415416798357f * 16.0f);
    return large < 31 ? large : 31;
}
__device__ __forceinline__ void ld8(const bf16_t* p, float (&o)[8]) {
    const u32x4 w = *(const u32x4*)p;
    o[0] = blo(w.x); o[1] = bhi(w.x); o[2] = blo(w.y); o[3] = bhi(w.y); o[4] = blo(w.z); o[5] = bhi(w.z); o[6] = blo(w.w); o[7] = bhi(w.w);
}

#define XB_TMO      128
#define XB_XCNT(j)  (256  + 64 * (j))
#define XB_XSUB(j)  (1280 + 64 * (j))
#define XB_XGEN(j)  (2304 + 64 * (j))
#define XB_TOP      3328
#define XB_TOPGEN   3392
#define XCD_BAR_WORDS 3456
#define XB_SPIN_CAP (1u << 18)
__device__ __forceinline__ unsigned xb_ld(unsigned* p)              { return __hip_atomic_load(p, __ATOMIC_RELAXED, __HIP_MEMORY_SCOPE_AGENT); }
__device__ __forceinline__ unsigned xb_add(unsigned* p, unsigned v) { return __hip_atomic_fetch_add(p, v, __ATOMIC_RELAXED, __HIP_MEMORY_SCOPE_AGENT); }
__device__ __forceinline__ unsigned xb_xcc_id() { return (unsigned)__builtin_amdgcn_s_getreg((3 << 11) | 20) & 0xFu; }
#define XB_SPIN(cond, bar) do { unsigned _sp = 0; while (cond) { __builtin_amdgcn_s_sleep(1); \
    if ((++_sp & 255u) == 0u) { if (xb_ld(&(bar)[XB_TMO])) break; if (_sp > XB_SPIN_CAP) { atomicAdd(&(bar)[XB_TMO], 1u); break; } } } } while (0)
struct XcdBarrier { unsigned* bar; unsigned x; volatile LAS unsigned* st; };
__device__ __forceinline__ XcdBarrier xcd_barrier_post(unsigned* bar, volatile LAS unsigned* st) {
    XcdBarrier b; b.bar = bar; b.x = xb_xcc_id(); b.st = st;
    if (threadIdx.x == 0) (void)xb_add(&bar[XB_XCNT(b.x)], 1u);
    return b;
}
__device__ __forceinline__ void xcd_barrier_complete(unsigned* bar, unsigned x, unsigned& nloc, unsigned& nx) {
    const unsigned G = gridDim.x * gridDim.y * gridDim.z;
    unsigned sum, cnt, mine, sp = 0u;
    for (;;) {
        sum = 0u; cnt = 0u; mine = 0u;
#pragma unroll
        for (unsigned j = 0; j < 16; ++j) { const unsigned c = xb_ld(&bar[XB_XCNT(j)]); sum += c; cnt += (c > 0u) ? 1u : 0u; mine = (j == x) ? c : mine; }
        if (sum == G) break;
        __builtin_amdgcn_s_sleep(1);
        if ((++sp & 255u) == 0u) { if (xb_ld(&bar[XB_TMO])) break; if (sp > XB_SPIN_CAP) { atomicAdd(&bar[XB_TMO], 1u); break; } }
    }
    nloc = mine > 0u ? mine : 1u; nx = cnt > 0u ? cnt : 1u;
}
__device__ __forceinline__ void xcd_barrier(const XcdBarrier& b) {
    asm volatile("s_waitcnt vmcnt(0)" ::: "memory");
    __syncthreads();
    if (threadIdx.x == 0) {
        unsigned* bar = b.bar;
        __builtin_amdgcn_s_waitcnt(0);
        unsigned nloc = b.st[0], nx = b.st[1];
        if (nloc == 0u) { xcd_barrier_complete(bar, b.x, nloc, nx); b.st[0] = nloc; b.st[1] = nx; }
        const unsigned old = xb_add(&bar[XB_XSUB(b.x)], 1u);
        const unsigned gen = old / nloc;
        if (old + 1u == (gen + 1u) * nloc) {
            __builtin_amdgcn_fence(__ATOMIC_RELEASE, "agent");
            asm volatile("s_waitcnt vmcnt(0)" ::: "memory");
            const unsigned og = xb_add(&bar[XB_TOP], 1u);
            const unsigned tg = og / nx;
            if (og + 1u == (tg + 1u) * nx) xb_add(&bar[XB_TOPGEN], 1u);
            else XB_SPIN(xb_ld(&bar[XB_TOPGEN]) == tg, bar);
            __builtin_amdgcn_fence(__ATOMIC_ACQUIRE, "agent");
            xb_add(&bar[XB_XGEN(b.x)], 1u);
            asm volatile("s_waitcnt vmcnt(0)" ::: "memory");
        } else {
            XB_SPIN(xb_ld(&bar[XB_XGEN(b.x)]) == gen, bar);
            __builtin_amdgcn_fence(__ATOMIC_ACQUIRE, "agent");
            asm volatile("s_waitcnt vmcnt(0)" ::: "memory");
        }
    }
    __syncthreads();
}

namespace pg8 {
constexpr int BM = 256, BK = 64, HALF = 128, HTB = HALF * BK * 2, STAGE_BYTES = 8 * HTB, NXCD = 8, WGM = 8;
__host__ __device__ __forceinline__ int lds_byte(int r, int c) { const int st = (r >> 4) * 2 + (c >> 5), rr = r & 15, cc = c & 31, ob = rr * 64 + cc * 2; return st * 1024 + (ob ^ (((ob >> 9) & 1) << 5)); }
__host__ __device__ __forceinline__ void stage_rc(int b, int& R, int& C) { const int st = b / 1024, sb = b % 1024, swz = sb ^ (((sb >> 9) & 1) << 5); R = (st >> 1) * 16 + swz / 64; C = (st & 1) * 32 + (swz % 64) / 2; }
__host__ __device__ __forceinline__ int perm32(int rho) { const int n = rho >> 4, i = rho & 15; return 8 * (i >> 2) + 4 * n + (i & 3); }

struct Unit { int pn, orow, e, mt, cnt; const char* a; const char* b; };

struct DenseSched {
    const char* A; const char* Bt; int K, nM, nN, nwg, G, c;
    __device__ void init(const void* A_, const void* Bt_, int M, int N, int K_, int G_, int c_) { A = (const char*)A_; Bt = (const char*)Bt_; K = K_; nM = M / BM; nN = N / BM; nwg = nM * nN; G = G_; c = c_; }
    __device__ __forceinline__ bool next(int i, Unit& u) const {
        const long L = (long)i * G + c; if (L >= nwg) return false;
        int wgid = (int)L; { const int q = nwg / NXCD, r = nwg % NXCD, xcd = wgid % NXCD, off = wgid / NXCD; wgid = (xcd < r ? xcd * (q + 1) : r * (q + 1) + (xcd - r) * q) + off; }
        const int nig = WGM * nN, gid = wgid / nig, fm = gid * WGM, gsz = (nM - fm) < WGM ? (nM - fm) : WGM;
        const int pm = fm + ((wgid % nig) % gsz); u.pn = (wgid % nig) / gsz; u.orow = pm * BM; u.e = 0; u.mt = pm; u.cnt = BM;
        u.a = A + (size_t)pm * BM * K * 2; u.b = Bt + (size_t)u.pn * BM * K * 2; return true;
    }
    __device__ __forceinline__ void a_offs(const Unit&, const int (&R)[2], const int (&C)[2], unsigned (&aro)[2][2]) const {
#pragma unroll
        for (int h = 0; h < 2; ++h)
#pragma unroll
            for (int i = 0; i < 2; ++i) aro[h][i] = (unsigned)((h * HALF + R[i]) * K + C[i]) * 2u;
    }
};
struct MoeSched {
    const char* A; const char* Bt; const int* list; const LAS int* mtp; const LAS int* cntv; int K, Kb, G, c; bool gather; size_t bstride;
    __device__ __forceinline__ bool next(int i, Unit& u) const {
        const int L = i * G + c; const int total = mtp[NEXP] * 4; if (L >= total) return false;
        const int gm = L >> 2; u.pn = L & 3; int e = 0;
#pragma unroll 1
        for (int j = 1; j < NEXP; ++j) e += (mtp[j] <= gm) ? 1 : 0;
        u.e = e; u.mt = gm - mtp[e]; u.cnt = cntv[e]; u.orow = gm * BM;
        u.a = gather ? A : A + (size_t)gm * BM * K * 2;
        u.b = Bt + (size_t)e * bstride + (size_t)u.pn * BM * Kb * 2; return true;
    }
    __device__ __forceinline__ void a_offs(const Unit& u, const int (&R)[2], const int (&C)[2], unsigned (&aro)[2][2]) const {
#pragma unroll
        for (int h = 0; h < 2; ++h)
#pragma unroll
            for (int i = 0; i < 2; ++i) {
                if (gather) { const int pos = u.mt * BM + h * HALF + R[i]; const int tok = pos < u.cnt ? list[(size_t)u.e * LIST_CAP + pos] : 0; aro[h][i] = (unsigned)(tok * K + C[i]) * 2u; }
                else aro[h][i] = (unsigned)((h * HALF + R[i]) * K + C[i]) * 2u;
            }
    }
};

struct EpiBf16 {
    static constexpr bool PERM = true;
    bf16_t* O; int ldc;
    __device__ __forceinline__ void operator()(const f32x4 (&acc)[2][2][4][2], const Unit& u, int wr, int wc, int fr, int fq) const {
        const int row0 = u.orow + wr * 64 + fr, col0 = u.pn * BM + wc * 32 + 8 * fq;
#pragma unroll
        for (int ai = 0; ai < 2; ++ai)
#pragma unroll
            for (int m = 0; m < 4; ++m) { bf16_t* rowp = O + (size_t)(row0 + ai * HALF + m * 16) * ldc + col0;
#pragma unroll
                for (int bj = 0; bj < 2; ++bj) { const f32x4 v0 = acc[ai][bj][m][0], v1 = acc[ai][bj][m][1];
                    u32x4 w; w.x = pk2(v0[0], v0[1]); w.y = pk2(v0[2], v0[3]); w.z = pk2(v1[0], v1[1]); w.w = pk2(v1[2], v1[3]);
                    *(u32x4*)(rowp + bj * HALF) = w; } }
    }
};
struct EpiGateUp {
    static constexpr bool PERM = true;
    bf16_t* O;
    __device__ __forceinline__ void operator()(const f32x4 (&acc)[2][2][4][2], const Unit& u, int wr, int wc, int fr, int fq) const {
        const int row0 = u.orow + wr * 64 + fr, col0 = (u.pn * BM + wc * 32 + 8 * fq) >> 1;
#pragma unroll
        for (int ai = 0; ai < 2; ++ai)
#pragma unroll
            for (int m = 0; m < 4; ++m) { bf16_t* rowp = O + (size_t)(row0 + ai * HALF + m * 16) * DEXP + col0;
#pragma unroll
                for (int bj = 0; bj < 2; ++bj) { const f32x4 v0 = acc[ai][bj][m][0], v1 = acc[ai][bj][m][1];
                    const float h0 = v0[0] * fast_sigmoid(v0[0]) * v0[1], h1 = v0[2] * fast_sigmoid(v0[2]) * v0[3];
                    const float h2 = v1[0] * fast_sigmoid(v1[0]) * v1[1], h3 = v1[2] * fast_sigmoid(v1[2]) * v1[3];
                    u32x2 w; w.x = pk2(h0, h1); w.y = pk2(h2, h3);
                    *(u32x2*)(rowp + bj * (HALF / 2)) = w; } }
    }
};
struct EpiResid {
    static constexpr bool PERM = false;
    const float* R; float* C;
    __device__ __forceinline__ void operator()(const f32x4 (&acc)[2][2][4][2], const Unit& u, int wr, int wc, int fr, int fq) const {
        const int row0 = u.orow + wr * 64 + fr, col0 = u.pn * BM + wc * 32 + 4 * fq;
#pragma unroll
        for (int ai = 0; ai < 2; ++ai)
#pragma unroll
            for (int m = 0; m < 4; ++m) { const size_t ro = (size_t)(row0 + ai * HALF + m * 16) * DM + col0;
#pragma unroll
                for (int bj = 0; bj < 2; ++bj)
#pragma unroll
                    for (int n = 0; n < 2; ++n) { const size_t o = ro + bj * HALF + n * 16; const f32x4 r = *(const f32x4*)(R + o); *(f32x4*)(C + o) = r + acc[ai][bj][m][n]; } }
    }
};
struct EpiPleGate {
    static constexpr bool PERM = false;
    float* H; const bf16_t* E; const float* erstd; const float* g;
    __device__ __forceinline__ void operator()(const f32x4 (&acc)[2][2][4][2], const Unit& u, int wr, int wc, int fr, int fq) const {
        const int row0 = u.orow + wr * 64 + fr, col0 = u.pn * BM + wc * 32 + 4 * fq;
        f32x4 gv[2][2];
#pragma unroll
        for (int bj = 0; bj < 2; ++bj)
#pragma unroll
            for (int n = 0; n < 2; ++n) gv[bj][n] = *(const f32x4*)(g + col0 + bj * HALF + n * 16);
#pragma unroll
        for (int ai = 0; ai < 2; ++ai)
#pragma unroll
            for (int m = 0; m < 4; ++m) { const int row = row0 + ai * HALF + m * 16; const size_t ro = (size_t)row * DM + col0; const float rs = erstd[row];
#pragma unroll
                for (int bj = 0; bj < 2; ++bj)
#pragma unroll
                    for (int n = 0; n < 2; ++n) { const size_t o = ro + bj * HALF + n * 16; const f32x4 h = *(const f32x4*)(H + o); const u32x2 ew = *(const u32x2*)(E + o); const f32x4 a = acc[ai][bj][m][n];
                        f32x4 r; r[0] = h[0] + blo(ew.x) * rs * gv[bj][n][0] * fast_sigmoid(a[0]); r[1] = h[1] + bhi(ew.x) * rs * gv[bj][n][1] * fast_sigmoid(a[1]);
                        r[2] = h[2] + blo(ew.y) * rs * gv[bj][n][2] * fast_sigmoid(a[2]); r[3] = h[3] + bhi(ew.y) * rs * gv[bj][n][3] * fast_sigmoid(a[3]);
                        *(f32x4*)(H + o) = r; } }
    }
};

template <class Epi, class Sched>
__device__ __forceinline__ void gemm_phase(LAS unsigned char* lds, const int K, const int Kb  , const Sched& S, const Epi& E) {
    int tid_ = threadIdx.x; asm volatile("" : "+v"(tid_));
    const int tid = tid_, wid = __builtin_amdgcn_readfirstlane(tid >> 6), lane = tid & 63, wr = wid >> 2, wc = wid & 3, fr = lane & 15, fq = lane >> 4;
    const int nt = K / BK;
    int Rr[2], Cc[2]; unsigned voffB[2];
#pragma unroll
    for (int i = 0; i < 2; ++i) { int R, C; stage_rc(tid * 16 + i * 8192, R, C); const int Rb = Epi::PERM ? ((R & ~31) + perm32(R & 31)) : R; Rr[i] = R; Cc[i] = C; voffB[i] = (unsigned)(Rb * Kb + C) * 2u; }
    const size_t kstep = (size_t)(BK * 2);
    const size_t hstepB = (size_t)HALF * Kb * 2;
    const unsigned ldsw = (unsigned)wid * 1024u;
    const int aoff = lds_byte(wr * 64 + fr, fq * 8), boff = lds_byte(wc * 32 + fr, fq * 8);
#define PG8_SA(b, h) (((b) * 2 + (h)) * HTB)
#define PG8_SB(b, h) ((4 + (b) * 2 + (h)) * HTB)
#define PG8_STAGE_B(bufoff, gbase) do { _Pragma("unroll") for (int _i = 0; _i < 2; ++_i) \
        __builtin_amdgcn_global_load_lds((const unsigned*)((const char*)(gbase) + voffB[_i]), (LAS unsigned*)(lds + (bufoff) + ldsw + _i * 8192), 16, 0, 0); } while (0)
#define PG8_STAGE_A(bufoff, gbase, o0, o1) do { \
        __builtin_amdgcn_global_load_lds((const unsigned*)((const char*)(gbase) + (o0)), (LAS unsigned*)(lds + (bufoff) + ldsw), 16, 0, 0); \
        __builtin_amdgcn_global_load_lds((const unsigned*)((const char*)(gbase) + (o1)), (LAS unsigned*)(lds + (bufoff) + ldsw + 8192), 16, 0, 0); } while (0)
#define PG8_LDA(dst, b, h) do { _Pragma("unroll") for (int m = 0; m < 4; ++m) _Pragma("unroll") for (int k = 0; k < 2; ++k) dst[m][k] = *(const LAS bf16x8*)(lds + PG8_SA(b, h) + aoff + m * 2048 + k * 1024); } while (0)
#define PG8_LDB(dst, b, h) do { _Pragma("unroll") for (int n = 0; n < 2; ++n) _Pragma("unroll") for (int k = 0; k < 2; ++k) dst[n][k] = *(const LAS bf16x8*)(lds + PG8_SB(b, h) + boff + n * 2048 + k * 1024); } while (0)
#define PG8_MMA(ai, bj, At, Bt) do { __builtin_amdgcn_s_setprio(1); _Pragma("unroll") for (int m = 0; m < 4; ++m) _Pragma("unroll") for (int n = 0; n < 2; ++n) _Pragma("unroll") for (int k = 0; k < 2; ++k) \
        acc[ai][bj][m][n] = __builtin_amdgcn_mfma_f32_16x16x32_bf16(Bt[n][k], At[m][k], acc[ai][bj][m][n], 0, 0, 0); __builtin_amdgcn_s_setprio(0); } while (0)
#define PG8_WAIT_V(n) asm volatile("s_waitcnt vmcnt(" #n ")" ::: "memory")
#define PG8_WAIT_L(n) asm volatile("s_waitcnt lgkmcnt(" #n ")" ::: "memory")
#define PG8_BAR __builtin_amdgcn_s_barrier()
#define PG8_SCHED __builtin_amdgcn_sched_barrier(0)
    Unit cur, nxt; int ui = 0;
    if (!S.next(0, cur)) return;
    f32x4 acc[2][2][4][2];
#pragma unroll
    for (int a = 0; a < 2; ++a)
#pragma unroll
        for (int b = 0; b < 2; ++b)
#pragma unroll
            for (int m = 0; m < 4; ++m)
#pragma unroll
                for (int n = 0; n < 2; ++n) acc[a][b][m][n] = (f32x4){0.f, 0.f, 0.f, 0.f};
    bf16x8 At[4][2], B0[2][2], B1[2][2];
    unsigned aroC[2][2], aroN[2][2];
    S.a_offs(cur, Rr, Cc, aroC);
    const char* cA = cur.a; const char* cB = cur.b;
    PG8_STAGE_B(PG8_SB(0, 0), cB); PG8_STAGE_A(PG8_SA(0, 0), cA, aroC[0][0], aroC[0][1]); PG8_STAGE_B(PG8_SB(0, 1), cB + hstepB); PG8_STAGE_A(PG8_SA(0, 1), cA, aroC[1][0], aroC[1][1]);
    if (wr == 1) PG8_BAR;
    PG8_WAIT_V(4); PG8_BAR;
    PG8_STAGE_B(PG8_SB(1, 0), cB + kstep); PG8_STAGE_A(PG8_SA(1, 0), cA + kstep, aroC[0][0], aroC[0][1]); PG8_STAGE_B(PG8_SB(1, 1), cB + hstepB + kstep);
    PG8_WAIT_V(6); PG8_BAR;
    for (;;) {
        const bool has_next = S.next(ui + 1, nxt);
        if (has_next) S.a_offs(nxt, Rr, Cc, aroN);
        else {
#pragma unroll
            for (int h = 0; h < 2; ++h)
#pragma unroll
                for (int i = 0; i < 2; ++i) aroN[h][i] = aroC[h][i];
        }
        const char* nA = has_next ? nxt.a : cA; const char* nB = has_next ? nxt.b : cB;
        for (int t = 0; t < nt; t += 2) {
            const bool last = (t == nt - 2);
            const char* a1 = cA + (size_t)(t + 1) * kstep;
            const char* a2 = last ? nA : cA + (size_t)(t + 2) * kstep; const char* b2 = last ? nB : cB + (size_t)(t + 2) * kstep;
            const char* a3 = a2 + kstep; const char* b3 = b2 + kstep;
            const unsigned x00 = last ? aroN[0][0] : aroC[0][0], x01 = last ? aroN[0][1] : aroC[0][1], x10 = last ? aroN[1][0] : aroC[1][0], x11 = last ? aroN[1][1] : aroC[1][1];
            PG8_LDB(B0, 0, 0); PG8_SCHED; PG8_LDA(At, 0, 0); PG8_STAGE_A(PG8_SA(1, 1), a1, aroC[1][0], aroC[1][1]);
            PG8_WAIT_L(8); PG8_BAR; PG8_WAIT_L(0); PG8_MMA(0, 0, At, B0); PG8_BAR; PG8_SCHED;
            PG8_LDB(B1, 0, 1); PG8_STAGE_B(PG8_SB(0, 0), b2);
            PG8_BAR; PG8_WAIT_L(0); PG8_MMA(0, 1, At, B1); PG8_BAR;
            PG8_LDA(At, 0, 1); PG8_STAGE_A(PG8_SA(0, 0), a2, x00, x01);
            PG8_BAR; PG8_WAIT_L(0); PG8_MMA(1, 0, At, B0); PG8_BAR; PG8_SCHED;
            PG8_STAGE_B(PG8_SB(0, 1), b2 + hstepB);
            PG8_WAIT_V(6); PG8_BAR; PG8_MMA(1, 1, At, B1); PG8_BAR;
            PG8_LDB(B0, 1, 0); PG8_SCHED; PG8_LDA(At, 1, 0); PG8_STAGE_A(PG8_SA(0, 1), a2, x10, x11);
            PG8_WAIT_L(8); PG8_BAR; PG8_WAIT_L(0); PG8_MMA(0, 0, At, B0); PG8_BAR; PG8_SCHED;
            PG8_LDB(B1, 1, 1); PG8_STAGE_B(PG8_SB(1, 0), b3);
            PG8_BAR; PG8_WAIT_L(0); PG8_MMA(0, 1, At, B1); PG8_BAR;
            PG8_LDA(At, 1, 1); PG8_STAGE_A(PG8_SA(1, 0), a3, x00, x01);
            PG8_BAR; PG8_WAIT_L(0); PG8_MMA(1, 0, At, B0); PG8_BAR; PG8_SCHED;
            PG8_STAGE_B(PG8_SB(1, 1), b3 + hstepB);
            PG8_WAIT_V(6); PG8_BAR; PG8_MMA(1, 1, At, B1); PG8_BAR;
        }
        E(acc, cur, wr, wc, fr, fq);
        if (!has_next) break;
#pragma unroll
        for (int a = 0; a < 2; ++a)
#pragma unroll
            for (int b = 0; b < 2; ++b)
#pragma unroll
                for (int m = 0; m < 4; ++m)
#pragma unroll
                    for (int n = 0; n < 2; ++n) acc[a][b][m][n] = (f32x4){0.f, 0.f, 0.f, 0.f};
        cur = nxt; cA = nA; cB = nB; ++ui;
#pragma unroll
        for (int h = 0; h < 2; ++h)
#pragma unroll
            for (int i = 0; i < 2; ++i) aroC[h][i] = aroN[h][i];
    }
    PG8_WAIT_V(0);
    if (wr == 0) PG8_BAR;
    PG8_BAR;
#undef PG8_SA
#undef PG8_SB
#undef PG8_STAGE_A
#undef PG8_STAGE_B
#undef PG8_LDA
#undef PG8_LDB
#undef PG8_MMA
#undef PG8_WAIT_V
#undef PG8_WAIT_L
#undef PG8_BAR
#undef PG8_SCHED
}
}

struct Params { const float* in[22]; float* out; unsigned char* ws; int ph_lo, ph_hi; };
struct Frame {
    LAS unsigned char* lds; int tid, lane, wave, G, bid;
    const Params* p; unsigned char* ws;
};
__device__ __forceinline__ Frame reframe(const Frame& F0) {
    Frame F = F0; int t = threadIdx.x; asm volatile("" : "+v"(t)); F.tid = t; F.lane = t & 63; F.wave = __builtin_amdgcn_readfirstlane(t >> 6); return F;
}

__device__ __forceinline__ void tr_item(const float* W, int K, int N, bf16_t* WT, int rmul, int radd, LAS float* scr, int item, int lane) {
    const int nblk = (N + 31) / 32, kb = item / nblk, nb = item % nblk, k0 = 64 * kb, n0 = 32 * nb;
    const int nn = n0 + (lane & 31); const bool ok = nn < N;
#pragma unroll 8
    for (int i = 0; i < 32; ++i) { const int kk = 2 * i + (lane >> 5); float v = 0.f; if (ok) v = W[(size_t)(k0 + kk) * N + nn]; scr[kk * 33 + (lane & 31)] = v; }
    asm volatile("s_waitcnt lgkmcnt(0)" ::: "memory");
    const int c = lane & 7;
#pragma unroll
    for (int j = 0; j < 4; ++j) { const int n = (lane >> 3) + 8 * j; const LAS float* s = scr + (8 * c) * 33 + n;
        u32x4 o; o.x = pk2(s[0 * 33], s[1 * 33]); o.y = pk2(s[2 * 33], s[3 * 33]); o.z = pk2(s[4 * 33], s[5 * 33]); o.w = pk2(s[6 * 33], s[7 * 33]);
        *(u32x4*)(WT + (size_t)((n0 + n) * rmul + radd) * K + k0 + 8 * c) = o; }
    asm volatile("s_waitcnt lgkmcnt(0)" ::: "memory");
}
__device__ __forceinline__ void phase_prologue(const Frame& F0) {
    const Frame F = reframe(F0);
    LAS float* scr = (LAS float*)(F.lds + F.wave * 16384);
    const int gw = F.bid * 8 + F.wave, NGW = F.G * 8;
    constexpr int I_IN = 16 * 79, I_OUT = 16 * 32, I_G = 16 * 16, I_D = 8 * 32, I_PLE = 4 * 32, I_PG = 16 * 32;
    constexpr int PER_L = I_IN + I_OUT + NEXP * 2 * I_G + NEXP * I_D + I_PLE + I_PG;
    for (int it = gw; it < 2 * PER_L; it += NGW) {
        const int L = it / PER_L; int r = it % PER_L;
        if (r < I_IN) { tr_item(F.p->in[4] + (size_t)L * DM * DIN, DM, DIN, (bf16_t*)(F.ws + WS_WIN + L * SZ_WIN), 1, 0, scr, r, F.lane); continue; } r -= I_IN;
        if (r < I_OUT) { tr_item(F.p->in[9] + (size_t)L * DM * DM, DM, DM, (bf16_t*)(F.ws + WS_WOUT + L * SZ_WOUT), 1, 0, scr, r, F.lane); continue; } r -= I_OUT;
        if (r < NEXP * 2 * I_G) { const int e = r / (2 * I_G), w = (r / I_G) & 1, q = r % I_G;
            tr_item(F.p->in[15 + w] + ((size_t)L * NEXP + e) * DM * DEXP, DM, DEXP, (bf16_t*)(F.ws + WS_WGU + L * SZ_WGU) + (size_t)e * 1024 * DM, 2, w, scr, q, F.lane); continue; } r -= NEXP * 2 * I_G;
        if (r < NEXP * I_D) { const int e = r / I_D, q = r % I_D;
            tr_item(F.p->in[17] + ((size_t)L * NEXP + e) * DEXP * DM, DEXP, DM, (bf16_t*)(F.ws + WS_WD + L * SZ_WD) + (size_t)e * DM * DEXP, 1, 0, scr, q, F.lane); continue; } r -= NEXP * I_D;
        if (r < I_PLE) { tr_item(F.p->in[18] + (size_t)L * PLE_D * DM, PLE_D, DM, (bf16_t*)(F.ws + WS_WPLE + L * SZ_WPLE), 1, 0, scr, r, F.lane); continue; } r -= I_PLE;
        tr_item(F.p->in[20] + (size_t)L * DM * DM, DM, DM, (bf16_t*)(F.ws + WS_WPG + L * SZ_WPG), 1, 0, scr, r, F.lane);
    }
    const float* pin = F.p->in[1]; bf16_t* pbf = (bf16_t*)(F.ws + WS_PBF);
    const size_t n8 = (size_t)2 * T_TOK * PLE_D / 8;
    for (size_t i = (size_t)F.bid * NTHREADS + F.tid; i < n8; i += (size_t)F.G * NTHREADS) {
        const f32x4 a = *(const f32x4*)(pin + i * 8), b = *(const f32x4*)(pin + i * 8 + 4);
        u32x4 o; o.x = pk2(a[0], a[1]); o.y = pk2(a[2], a[3]); o.z = pk2(b[0], b[1]); o.w = pk2(b[2], b[3]);
        *(u32x4*)(pbf + i * 8) = o;
    }
}

__device__ __forceinline__ void phase_norm_bf16(const Frame& F0, const float* X, const float* g, bf16_t* Y) {
    const Frame F = reframe(F0);
    const int gw = F.bid * 8 + F.wave, NGW = F.G * 8;
    f32x4 gv[4];
#pragma unroll
    for (int j = 0; j < 4; ++j) gv[j] = *(const f32x4*)(g + 4 * F.lane + 256 * j);
    for (int row = gw; row < T_TOK; row += NGW) {
        const f32x4* xr = (const f32x4*)(X + (size_t)row * DM) + F.lane;
        f32x4 v[4]; float s = 0.f;
#pragma unroll
        for (int j = 0; j < 4; ++j) { v[j] = xr[64 * j]; s += v[j][0] * v[j][0] + v[j][1] * v[j][1] + v[j][2] * v[j][2] + v[j][3] * v[j][3]; }
        const float r = rsqrtf(wave_sum(s) * (1.0f / DM) + EPS);
        u32x2* o8 = (u32x2*)(Y + (size_t)row * DM) + F.lane;
#pragma unroll
        for (int j = 0; j < 4; ++j) { u32x2 o; o.x = pk2(v[j][0] * r * gv[j][0], v[j][1] * r * gv[j][1]); o.y = pk2(v[j][2] * r * gv[j][2], v[j][3] * r * gv[j][3]); o8[64 * j] = o; }
    }
}
__device__ __forceinline__ void phase_final(const Frame& F0, const float* X, const float* g, float* Y) {
    const Frame F = reframe(F0);
    const int gw = F.bid * 8 + F.wave, NGW = F.G * 8;
    f32x4 gv[4];
#pragma unroll
    for (int j = 0; j < 4; ++j) gv[j] = *(const f32x4*)(g + 4 * F.lane + 256 * j);
    for (int row = gw; row < T_TOK; row += NGW) {
        const f32x4* xr = (const f32x4*)(X + (size_t)row * DM) + F.lane;
        f32x4 v[4]; float s = 0.f;
#pragma unroll
        for (int j = 0; j < 4; ++j) { v[j] = xr[64 * j]; s += v[j][0] * v[j][0] + v[j][1] * v[j][1] + v[j][2] * v[j][2] + v[j][3] * v[j][3]; }
        const float r = rsqrtf(wave_sum(s) * (1.0f / DM) + EPS);
        f32x4* o = (f32x4*)(Y + (size_t)row * DM) + F.lane;
#pragma unroll
        for (int j = 0; j < 4; ++j) { f32x4 w; w[0] = v[j][0] * r * gv[j][0]; w[1] = v[j][1] * r * gv[j][1]; w[2] = v[j][2] * r * gv[j][2]; w[3] = v[j][3] * r * gv[j][3]; o[64 * j] = w; }
    }
}

__device__ __forceinline__ void gla_cumdecay(const Frame& F, const bf16_t* P, int tile, const float* wa, const float* ba, LAS float* bq, LAS float* tmp  ) {
    LAS float* ga = tmp; LAS float* was = tmp + 1024; LAS float* bas = tmp + 1024 + 2048;
    for (int i = F.tid; i < 1024; i += NTHREADS) { const int t = i >> 4, r = i & 15; ga[i] = bf2f(P[(size_t)(tile * 64 + t) * DINP + C_GA + r]); }
    for (int i = F.tid; i < 2048; i += NTHREADS) was[i] = wa[i];
    if (F.tid < 128) bas[F.tid] = ba[F.tid];
    __syncthreads();
#pragma unroll 4
    for (int i = 0; i < 16; ++i) {
        const int idx = F.tid + NTHREADS * i, t = idx >> 7, j = idx & 127;
        float x = 0.f;
#pragma unroll
        for (int r = 0; r < 16; ++r) x += ga[t * 16 + r] * was[r * 128 + j];
        x += bas[j];
        const float ls = fminf(x, 0.f) - log1pf(expf(-fabsf(x)));
        bq[idx] = ls * (1.0f / 16.0f);
    }
    __syncthreads();
    if (F.tid < 128) { float run = 0.f; for (int t = 0; t < 64; ++t) { run += bq[t * 128 + F.tid]; bq[t * 128 + F.tid] = run; } }
    __syncthreads();
}
__device__ __forceinline__ void gla_local(const Frame& F0, int L) {
    const Frame F = reframe(F0);
    const bf16_t* P = (const bf16_t*)(F.ws + WS_P);
    float* GU = (float*)(F.ws + WS_GU); float* GD = (float*)(F.ws + WS_GD);
    LAS float* bq = (LAS float*)F.lds;
    LAS float* kk = bq + 8192;
    LAS float* vv = kk + 8192;
    LAS float* tmp = vv + 16384;
    for (int tile = F.bid; tile < 256; tile += F.G) {
        __syncthreads();
        gla_cumdecay(F, P, tile, F.p->in[5] + L * 2048, F.p->in[6] + L * 128, bq, tmp);
        for (int c = F.tid; c < 1024; c += NTHREADS) { const int s = c >> 4, j8 = (c & 15) * 8; float f[8]; ld8(P + (size_t)(tile * 64 + s) * DINP + C_GK + j8, f);
#pragma unroll
            for (int q = 0; q < 8; ++q) kk[s * 128 + j8 + q] = f[q] * expf(bq[63 * 128 + j8 + q] - bq[s * 128 + j8 + q]); }
        for (int c = F.tid; c < 2048; c += NTHREADS) { const int s = c >> 5, j8 = (c & 31) * 8; float f[8]; ld8(P + (size_t)(tile * 64 + s) * DINP + C_GV + j8, f);
#pragma unroll
            for (int q = 0; q < 8; ++q) vv[s * 256 + j8 + q] = f[q]; }
        __syncthreads();
        const int vq = F.tid & 15, kq = (F.tid >> 4) & 7, h = F.tid >> 7;
        f32x4 u[4];
#pragma unroll
        for (int i = 0; i < 4; ++i) u[i] = (f32x4){0.f, 0.f, 0.f, 0.f};
        for (int s = 0; s < 64; ++s) {
            const f32x4 kv = *(const LAS f32x4*)(kk + s * 128 + h * 32 + kq * 4);
            const f32x4 v4 = *(const LAS f32x4*)(vv + s * 256 + h * 64 + vq * 4);
#pragma unroll
            for (int i = 0; i < 4; ++i) u[i] += kv[i] * v4;
        }
        float* up = GU + ((size_t)tile * 4 + h) * 2048 + (kq * 4) * 64 + vq * 4;
#pragma unroll
        for (int i = 0; i < 4; ++i) *(f32x4*)(up + i * 64) = u[i];
        if (F.tid < 128) GD[(size_t)tile * 128 + F.tid] = expf(bq[63 * 128 + F.tid]);
    }
}
__device__ __forceinline__ void gla_final(const Frame& F0, int L) {
    const Frame F = reframe(F0);
    const bf16_t* P = (const bf16_t*)(F.ws + WS_P);
    const float* GU = (const float*)(F.ws + WS_GU); const float* GD = (const float*)(F.ws + WS_GD);
    bf16_t* OM = (bf16_t*)(F.ws + WS_OMIX);
    const float* gnorm = F.p->in[7] + L * 64;
    LAS float* bq = (LAS float*)F.lds;
    LAS float* qtT = bq + 8192;
    LAS float* ktT = qtT + 2048;
    LAS float* vs = ktT + 2048;
    LAS float* Ss = vs + 4096;
    LAS float* AT = Ss + 2048;
    LAS float* tmp = AT + 4096;
    for (int tile = F.bid; tile < 256; tile += F.G) {
        __syncthreads();
        gla_cumdecay(F, P, tile, F.p->in[5] + L * 2048, F.p->in[6] + L * 128, bq, tmp);
        const int cb = tile & 31, tile0 = tile - cb;
        for (int h = 0; h < 4; ++h) {
            { const int e4 = F.tid * 4, k = e4 >> 6; f32x4 S = (f32x4){0.f, 0.f, 0.f, 0.f};
              for (int c = 0; c < cb; ++c) { const float d = GD[(size_t)(tile0 + c) * 128 + h * 32 + k]; const f32x4 u = *(const f32x4*)(GU + ((size_t)(tile0 + c) * 4 + h) * 2048 + e4); S = S * d + u; }
              *(LAS f32x4*)(Ss + e4) = S; }
            { const int t = F.tid >> 3, k4 = (F.tid & 7) * 4;
              const u32x2 qw = *(const u32x2*)(P + (size_t)(tile * 64 + t) * DINP + C_GQ + h * 32 + k4);
              const u32x2 kw = *(const u32x2*)(P + (size_t)(tile * 64 + t) * DINP + C_GK + h * 32 + k4);
              const float qf[4] = {blo(qw.x), bhi(qw.x), blo(qw.y), bhi(qw.y)}, kf[4] = {blo(kw.x), bhi(kw.x), blo(kw.y), bhi(kw.y)};
#pragma unroll
              for (int q = 0; q < 4; ++q) { const float bb = bq[t * 128 + h * 32 + k4 + q]; qtT[(k4 + q) * 64 + t] = qf[q] * 0.17677669529663687f * expf(bb); ktT[(k4 + q) * 64 + t] = kf[q] * expf(-bb); } }
            { const int s = F.tid >> 3, j8 = (F.tid & 7) * 8; float f[8]; ld8(P + (size_t)(tile * 64 + s) * DINP + C_GV + h * 64 + j8, f);
#pragma unroll
              for (int q = 0; q < 8; ++q) vs[s * 64 + j8 + q] = f[q]; }
            __syncthreads();
            const int tq = F.tid >> 4, xq = F.tid & 15;
            { f32x4 a0 = (f32x4){0.f, 0.f, 0.f, 0.f}, a1 = a0;
              for (int k = 0; k < 32; ++k) { const f32x2 q2 = *(const LAS f32x2*)(qtT + k * 64 + 2 * tq); const f32x4 k4 = *(const LAS f32x4*)(ktT + k * 64 + 4 * xq); a0 += q2[0] * k4; a1 += q2[1] * k4; }
#pragma unroll
              for (int j = 0; j < 4; ++j) { const int s = 4 * xq + j; f32x2 w; w[0] = (s <= 2 * tq) ? a0[j] : 0.f; w[1] = (s <= 2 * tq + 1) ? a1[j] : 0.f; *(LAS f32x2*)(AT + s * 64 + 2 * tq) = w; } }
            __syncthreads();
            { f32x4 o0 = (f32x4){0.f, 0.f, 0.f, 0.f}, o1 = o0;
              for (int k = 0; k < 32; ++k) { const f32x2 q2 = *(const LAS f32x2*)(qtT + k * 64 + 2 * tq); const f32x4 s4 = *(const LAS f32x4*)(Ss + k * 64 + 4 * xq); o0 += q2[0] * s4; o1 += q2[1] * s4; }
              for (int s = 0; s < 64; ++s) { const f32x2 a2 = *(const LAS f32x2*)(AT + s * 64 + 2 * tq); const f32x4 v4 = *(const LAS f32x4*)(vs + s * 64 + 4 * xq); o0 += a2[0] * v4; o1 += a2[1] * v4; }
              float s0 = o0[0] * o0[0] + o0[1] * o0[1] + o0[2] * o0[2] + o0[3] * o0[3], s1 = o1[0] * o1[0] + o1[1] * o1[1] + o1[2] * o1[2] + o1[3] * o1[3];
#pragma unroll
              for (int o = 1; o < 16; o <<= 1) { s0 += __shfl_xor(s0, o); s1 += __shfl_xor(s1, o); }
              const float r0 = rsqrtf(s0 * (1.0f / 64.0f) + EPS), r1 = rsqrtf(s1 * (1.0f / 64.0f) + EPS);
              const f32x4 gn = *(const f32x4*)(gnorm + 4 * xq);
#pragma unroll
              for (int rr = 0; rr < 2; ++rr) { const int t = 2 * tq + rr; const size_t row = (size_t)(tile * 64 + t);
                  const u32x2 gw = *(const u32x2*)(P + row * DINP + C_GG + h * 64 + 4 * xq);
                  const float gg[4] = {blo(gw.x), bhi(gw.x), blo(gw.y), bhi(gw.y)};
                  const f32x4 ov = rr ? o1 : o0; const float rs = rr ? r1 : r0;
                  float w[4];
#pragma unroll
                  for (int j = 0; j < 4; ++j) w[j] = ov[j] * rs * gn[j] * (gg[j] * fast_sigmoid(gg[j]));
                  u32x2 o; o.x = pk2(w[0], w[1]); o.y = pk2(w[2], w[3]);
                  *(u32x2*)(OM + row * DM + h * 64 + 4 * xq) = o; } }
            __syncthreads();
        }
    }
}

__device__ __forceinline__ int half_sum_i(int v, LAS int* red  , int hf, int w4) {
#pragma unroll
    for (int o = 32; o > 0; o >>= 1) v += __shfl_xor(v, o);
    __syncthreads();
    if ((threadIdx.x & 63) == 0) red[hf * 4 + w4] = v;
    __syncthreads();
    return red[hf * 4] + red[hf * 4 + 1] + red[hf * 4 + 2] + red[hf * 4 + 3];
}
__device__ __forceinline__ void dsa_simple(const Frame& F0) {
    const Frame F = reframe(F0);
    const bf16_t* P = (const bf16_t*)(F.ws + WS_P);
    bf16_t* OM = (bf16_t*)(F.ws + WS_OMIX);
    const float* rel_bias = F.p->in[2];
    const int hf = F.tid >> 8, tid = F.tid & 255, w4 = tid >> 6;
    LAS float* base = (LAS float*)(F.lds + hf * 49152);
    LAS float* qi = base;
    LAS float* qd = base + 512;
    LAS float* wq = base + 768;
    LAS float* lg = base + 1024;
    LAS unsigned* kl = (LAS unsigned*)(base + 1024 + 8192);
    LAS float* redf = base + 1024 + 8192 + 2048;
    LAS int* red = (LAS int*)(F.lds + 2 * 49152);
    for (int tile = F.bid; tile < 256; tile += F.G) {
#pragma unroll 1
        for (int it = 0; it < 32; ++it) {
            const int tg = tile * 64 + it * 2 + hf, b = tg / SEQ, t = tg % SEQ;
            __syncthreads();
            const bf16_t* pr = P + (size_t)tg * DINP;
            qi[tid] = bf2f(pr[C_IQ + tid]); qi[tid + 256] = bf2f(pr[C_IQ + 256 + tid]);
            qd[tid] = bf2f(pr[C_DQ + tid]) * 0.125f;
            if (tid < 8) wq[tid] = bf2f(pr[C_IW + tid]) * 0.04419417382415922f;
            __syncthreads();
#pragma unroll 1
            for (int i = 0; i < 8; ++i) {
                const int s = tid + 256 * i;
                unsigned key = 0u;
                if (s <= t) {
                    const bf16_t* kr = P + (size_t)(b * SEQ + s) * DINP + C_IK;
                    float sc = 0.f;
#pragma unroll 1
                    for (int h = 0; h < 8; ++h) {
                        float acc = 0.f;
#pragma unroll 2
                        for (int d = 0; d < 64; d += 8) {
                            float kv[8]; ld8(kr + d, kv);
#pragma unroll
                            for (int q = 0; q < 8; ++q) acc += qi[h * 64 + d + q] * kv[q];
                        }
                        sc += wq[h] * fmaxf(acc, 0.f);
                    }
                    sc += 0.0f;
                    const unsigned u = __float_as_uint(sc);
                    key = (u & 0x80000000u) ? ~u : (u | 0x80000000u);
                }
                kl[s] = key;
            }
            unsigned K = 0u;
#pragma unroll 1
            for (int bit = 31; bit >= 0; --bit) {
                const unsigned cand = K | (1u << bit);
                int c = 0;
#pragma unroll 1
                for (int i = 0; i < 8; ++i) c += (kl[tid + 256 * i] >= cand) ? 1 : 0;
                if (half_sum_i(c, red, hf, w4) >= 256) K = cand;
            }
            int cg = 0;
#pragma unroll 1
            for (int i = 0; i < 8; ++i) cg += (kl[tid + 256 * i] > K) ? 1 : 0;
            const int r = 256 - half_sum_i(cg, red, hf, w4);
            int lo = 0, hi = SEQ - 1;
#pragma unroll 1
            for (int itb = 0; itb < 11; ++itb) {
                const int mid = (lo + hi) >> 1;
                int c = 0;
#pragma unroll 1
                for (int i = 0; i < 8; ++i) c += (kl[tid + 256 * i] == K && (tid + 256 * i) <= mid) ? 1 : 0;
                const int tot = half_sum_i(c, red, hf, w4);
                if (lo < hi) { if (tot >= r) hi = mid; else lo = mid + 1; }
            }
            int cut = lo;
            if (t + 1 <= 256) { K = 0u; cut = SEQ; }
            float mx0 = -INFINITY, mx1 = -INFINITY, mx2 = -INFINITY, mx3 = -INFINITY;
#pragma unroll 1
            for (int i = 0; i < 8; ++i) {
                const int s = tid + 256 * i;
                const unsigned key = kl[s];
                const bool sel = (s <= t) && (key > K || (key == K && s <= cut));
                float l0 = -INFINITY, l1 = -INFINITY, l2 = -INFINITY, l3 = -INFINITY;
                if (sel) {
                    const bf16_t* kr = P + (size_t)(b * SEQ + s) * DINP + C_DK;
                    float a0 = 0.f, a1 = 0.f, a2 = 0.f, a3 = 0.f;
#pragma unroll 2
                    for (int d = 0; d < 64; d += 8) {
                        float kv[8]; ld8(kr + d, kv);
#pragma unroll
                        for (int q = 0; q < 8; ++q) { a0 += qd[d + q] * kv[q]; a1 += qd[64 + d + q] * kv[q]; a2 += qd[128 + d + q] * kv[q]; a3 += qd[192 + d + q] * kv[q]; }
                    }
                    const int bk = rel_bucket(t - s);
                    l0 = a0 + rel_bias[bk * 12 + 0]; l1 = a1 + rel_bias[bk * 12 + 1]; l2 = a2 + rel_bias[bk * 12 + 2]; l3 = a3 + rel_bias[bk * 12 + 3];
                    mx0 = fmaxf(mx0, l0); mx1 = fmaxf(mx1, l1); mx2 = fmaxf(mx2, l2); mx3 = fmaxf(mx3, l3);
                }
                lg[s] = l0; lg[2048 + s] = l1; lg[4096 + s] = l2; lg[6144 + s] = l3;
            }
            mx0 = wave_max(mx0); mx1 = wave_max(mx1); mx2 = wave_max(mx2); mx3 = wave_max(mx3);
            if ((tid & 63) == 0) { redf[w4 * 8 + 0] = mx0; redf[w4 * 8 + 1] = mx1; redf[w4 * 8 + 2] = mx2; redf[w4 * 8 + 3] = mx3; }
            __syncthreads();
            {
                const int h = tid >> 6;
                const float m = fmaxf(fmaxf(redf[h], redf[8 + h]), fmaxf(redf[16 + h], redf[24 + h]));
                float sm = 0.f;
#pragma unroll 1
                for (int s = (tid & 63); s < 2048; s += 64) { const float l = lg[h * 2048 + s]; const float e = (l == -INFINITY) ? 0.f : expf(l - m); lg[h * 2048 + s] = e; sm += e; }
                sm = wave_sum(sm);
                const int d = tid & 63;
                float acc = 0.f;
                const bf16_t* vb = P + (size_t)(b * SEQ) * DINP + C_DV + d;
#pragma unroll 1
                for (int s = 0; s <= t; ++s) {
                    const float pv = lg[h * 2048 + s];
                    if (pv != 0.f) acc += pv * bf2f(vb[(size_t)s * DINP]);
                }
                OM[(size_t)tg * DM + 256 + h * 64 + d] = (bf16_t)(pk2(acc / sm, 0.f) & 0xffffu);
            }
        }
    }
}

__device__ __forceinline__ void swa_simple(const Frame& F0, int L) {
    const Frame F = reframe(F0);
    const bf16_t* P = (const bf16_t*)(F.ws + WS_P);
    bf16_t* OM = (bf16_t*)(F.ws + WS_OMIX);
    const float* rel_bias = F.p->in[2]; const float* sinks = F.p->in[8] + L * 8;
    const int hf = F.tid >> 8, tid = F.tid & 255;
    LAS float* q = (LAS float*)(F.lds + hf * 8192);
    LAS float* lg = q + 512;
    for (int tile = F.bid; tile < 256; tile += F.G) {
        for (int it = 0; it < 32; ++it) {
            const int tg = tile * 64 + it * 2 + hf, b = tg / SEQ, t = tg % SEQ;
            __syncthreads();
            const bf16_t* pr = P + (size_t)tg * DINP;
            q[tid] = bf2f(pr[C_SQ + tid]) * 0.125f; q[tid + 256] = bf2f(pr[C_SQ + 256 + tid]) * 0.125f;
            __syncthreads();
#pragma unroll
            for (int i = 0; i < 4; ++i) {
                const int idx = tid + 256 * i, h = idx >> 7, j = idx & 127, s = t - 127 + j;
                float l = -INFINITY;
                if (s >= 0) {
                    const bf16_t* kr = P + (size_t)(b * SEQ + s) * DINP + C_SK + (h >> 2) * 64;
                    float acc = 0.f;
                    for (int d = 0; d < 64; d += 8) { float kv[8]; ld8(kr + d, kv);
#pragma unroll
                        for (int qq = 0; qq < 8; ++qq) acc += q[h * 64 + d + qq] * kv[qq]; }
                    l = acc + rel_bias[rel_bucket(127 - j) * 12 + 4 + h];
                }
                lg[idx] = l;
            }
            __syncthreads();
            {
                const int w = tid >> 6, lane = tid & 63;
#pragma unroll
                for (int hh = 0; hh < 2; ++hh) {
                    const int h = w * 2 + hh;
                    const float l0 = lg[h * 128 + lane], l1 = lg[h * 128 + 64 + lane];
                    const float sk = sinks[h];
                    const float m = fmaxf(wave_max(fmaxf(l0, l1)), sk);
                    const float e0 = expf(l0 - m), e1 = expf(l1 - m);
                    const float den = wave_sum(e0 + e1) + expf(sk - m);
                    lg[h * 128 + lane] = e0 / den; lg[h * 128 + 64 + lane] = e1 / den;
                }
            }
            __syncthreads();
#pragma unroll
            for (int i = 0; i < 2; ++i) {
                const int idx = tid + 256 * i, h = idx >> 6, d = idx & 63;
                float acc = 0.f;
                for (int j = 0; j < 128; ++j) {
                    const int s = t - 127 + j;
                    if (s >= 0) acc += lg[h * 128 + j] * bf2f(P[(size_t)(b * SEQ + s) * DINP + C_SV + (h >> 2) * 64 + d]);
                }
                OM[(size_t)tg * DM + 512 + h * 64 + d] = (bf16_t)(pk2(acc, 0.f) & 0xffffu);
            }
        }
    }
}

__device__ __forceinline__ void phase_route(const Frame& F0, int L) {
    const Frame F = reframe(F0);
    const float* H = (const float*)(F.ws + WS_H);
    bf16_t* XN = (bf16_t*)(F.ws + WS_ABF);
    const float* g = F.p->in[10] + L * DM;
    const float* wrg = F.p->in[11] + (size_t)L * DM * 4; const float* brg = F.p->in[12] + L * 4;
    const float* wre = F.p->in[13] + (size_t)L * DM * 32; const float* bre = F.p->in[14] + L * 32;
    unsigned* cursor = (unsigned*)(F.ws + WS_CTL) + CW_CURSOR + L * 32;
    int* list = (int*)(F.ws + WS_LIST); unsigned* slot = (unsigned*)(F.ws + WS_SLOT); float* gate = (float*)(F.ws + WS_GATE);
    LAS float* wl = (LAS float*)F.lds;
    LAS float* lgs = (LAS float*)(F.lds + MISC_OFF + 64);
    LAS int* sl_e = (LAS int*)(F.lds + MISC_OFF + 64 + 8 * 72 * 4);
    LAS int* sl_rank = sl_e + 128;
    LAS int* lcnt = sl_rank + 128;
    LAS int* gbase = lcnt + 32;
    __syncthreads();
    for (int i = F.tid; i < DM * 4; i += NTHREADS) { const int k = i >> 2, j = i & 3; wl[j * 1024 + k] = wrg[i]; }
    for (int i = F.tid; i < DM * 32; i += NTHREADS) { const int k = i >> 5, j = i & 31; wl[(4 + j) * 1024 + k] = wre[i]; }
    f32x4 gv[4];
#pragma unroll
    for (int j = 0; j < 4; ++j) gv[j] = *(const f32x4*)(g + 4 * F.lane + 256 * j);
    for (int tile = F.bid; tile < 256; tile += F.G) {
        if (F.tid < 32) lcnt[F.tid] = 0;
        __syncthreads();
        for (int pr = 0; pr < 4; ++pr) {
            const int t0 = tile * 64 + F.wave * 8 + pr * 2;
            f32x4 xa[4], xb[4]; float sa = 0.f, sb = 0.f;
#pragma unroll
            for (int j = 0; j < 4; ++j) { xa[j] = *((const f32x4*)(H + (size_t)t0 * DM) + F.lane + 64 * j); xb[j] = *((const f32x4*)(H + (size_t)(t0 + 1) * DM) + F.lane + 64 * j);
                sa += xa[j][0] * xa[j][0] + xa[j][1] * xa[j][1] + xa[j][2] * xa[j][2] + xa[j][3] * xa[j][3]; sb += xb[j][0] * xb[j][0] + xb[j][1] * xb[j][1] + xb[j][2] * xb[j][2] + xb[j][3] * xb[j][3]; }
            const float ra = rsqrtf(wave_sum(sa) * (1.0f / DM) + EPS), rb = rsqrtf(wave_sum(sb) * (1.0f / DM) + EPS);
#pragma unroll
            for (int j = 0; j < 4; ++j) {
#pragma unroll
                for (int q = 0; q < 4; ++q) { xa[j][q] = xa[j][q] * ra * gv[j][q]; xb[j][q] = xb[j][q] * rb * gv[j][q]; }
                u32x2 oa, ob; oa.x = pk2(xa[j][0], xa[j][1]); oa.y = pk2(xa[j][2], xa[j][3]); ob.x = pk2(xb[j][0], xb[j][1]); ob.y = pk2(xb[j][2], xb[j][3]);
                *((u32x2*)(XN + (size_t)t0 * DM) + F.lane + 64 * j) = oa; *((u32x2*)(XN + (size_t)(t0 + 1) * DM) + F.lane + 64 * j) = ob;
            }
#pragma unroll 4
            for (int jj = 0; jj < 36; ++jj) {
                float da = 0.f, db = 0.f;
#pragma unroll
                for (int j = 0; j < 4; ++j) { const f32x4 w = *(const LAS f32x4*)(wl + jj * 1024 + 4 * F.lane + 256 * j);
                    da += xa[j][0] * w[0] + xa[j][1] * w[1] + xa[j][2] * w[2] + xa[j][3] * w[3]; db += xb[j][0] * w[0] + xb[j][1] * w[1] + xb[j][2] * w[2] + xb[j][3] * w[3]; }
                da = wave_sum(da); db = wave_sum(db);
                if (F.lane == 0) { lgs[F.wave * 72 + jj] = da; lgs[F.wave * 72 + 36 + jj] = db; }
            }
            asm volatile("s_waitcnt lgkmcnt(0)" ::: "memory");
            if (F.lane < 2) {
                const LAS float* lgp = lgs + F.wave * 72 + F.lane * 36; const int t = t0 + F.lane;
                float gl[4], m = -INFINITY;
                for (int j = 0; j < 4; ++j) { gl[j] = lgp[j] + brg[j]; m = fmaxf(m, gl[j]); }
                float sum = 0.f; for (int j = 0; j < 4; ++j) { gl[j] = expf(gl[j] - m); sum += gl[j]; }
                int gs = 0; float gw = gl[0] / sum;
                for (int j = 1; j < 4; ++j) { const float pj = gl[j] / sum; if (pj > gw) { gw = pj; gs = j; } }
                float el[8]; m = -INFINITY;
                for (int j = 0; j < 8; ++j) { el[j] = lgp[4 + gs * 8 + j] + bre[gs * 8 + j]; m = fmaxf(m, el[j]); }
                sum = 0.f; for (int j = 0; j < 8; ++j) { el[j] = expf(el[j] - m); sum += el[j]; }
                for (int j = 0; j < 8; ++j) el[j] = el[j] / sum;
                int i1 = 0; float e1v = el[0];
                for (int j = 1; j < 8; ++j) if (el[j] > e1v) { e1v = el[j]; i1 = j; }
                int i2 = -1; float e2v = -1.f;
                for (int j = 0; j < 8; ++j) if (j != i1 && el[j] > e2v) { e2v = el[j]; i2 = j; }
                const float es = e1v + e2v;
                const int ls = (t - tile * 64) * 2;
                sl_e[ls] = (gs * 8 + i1) & 31; sl_e[ls + 1] = (gs * 8 + i2) & 31;
                gate[2 * t] = gw * e1v / es; gate[2 * t + 1] = gw * e2v / es;
            }
        }
        __syncthreads();
        if (F.tid < 128) sl_rank[F.tid] = atomicAdd((int*)&lcnt[sl_e[F.tid]], 1);
        __syncthreads();
        if (F.tid < 32) gbase[F.tid] = (int)__hip_atomic_fetch_add(&cursor[F.tid], (unsigned)lcnt[F.tid], __ATOMIC_RELAXED, __HIP_MEMORY_SCOPE_AGENT);
        __syncthreads();
        if (F.tid < 128) { const int e = sl_e[F.tid], pos = gbase[e] + sl_rank[F.tid], t = tile * 64 + (F.tid >> 1);
            list[(size_t)e * LIST_CAP + pos] = t; slot[2 * t + (F.tid & 1)] = ((unsigned)e << 16) | (unsigned)pos; }
        __syncthreads();
    }
}
__device__ __forceinline__ void moe_tables(const Frame& F0, int L, LAS int* cntv, LAS int* mtp) {
    const Frame F = reframe(F0);
    unsigned* cursor = (unsigned*)(F.ws + WS_CTL) + CW_CURSOR + L * 32;
    __syncthreads();
    if (F.tid < 32) cntv[F.tid] = (int)__hip_atomic_load(&cursor[F.tid], __ATOMIC_RELAXED, __HIP_MEMORY_SCOPE_AGENT);
    __syncthreads();
    if (F.tid == 0) { int run = 0; for (int e = 0; e < NEXP; ++e) { mtp[e] = run; run += (cntv[e] + 255) >> 8; } mtp[NEXP] = run; }
    __syncthreads();
}
__device__ __forceinline__ void phase_combine(const Frame& F0, int L) {
    const Frame F = reframe(F0);
    float* H = (float*)(F.ws + WS_H); bf16_t* HB = (bf16_t*)(F.ws + WS_ABF);
    const bf16_t* Y = (const bf16_t*)(F.ws + WS_P); const bf16_t* EP = (const bf16_t*)(F.ws + WS_EPRE);
    const unsigned* slot = (const unsigned*)(F.ws + WS_SLOT); const float* gate = (const float*)(F.ws + WS_GATE); float* erstd = (float*)(F.ws + WS_ERSTD);
    LAS int* cntv = (LAS int*)(F.lds + MISC_OFF + 64); LAS int* mtp = cntv + 32;
    moe_tables(F, L, cntv, mtp);
    const int gw = F.bid * 8 + F.wave, NGW = F.G * 8;
    for (int t = gw; t < T_TOK; t += NGW) {
        const unsigned s0 = slot[2 * t], s1 = slot[2 * t + 1];
        size_t r0 = (size_t)mtp[(s0 >> 16) & 31] * 256 + (s0 & 0x7fffu), r1 = (size_t)mtp[(s1 >> 16) & 31] * 256 + (s1 & 0x7fffu);
        r0 = r0 < MOE_PROWS ? r0 : 0; r1 = r1 < MOE_PROWS ? r1 : 0;
        const float g0 = gate[2 * t], g1 = gate[2 * t + 1];
        float ss = 0.f;
#pragma unroll
        for (int j = 0; j < 4; ++j) {
            const u32x2 ya = *((const u32x2*)(Y + r0 * DM) + F.lane + 64 * j), yb = *((const u32x2*)(Y + r1 * DM) + F.lane + 64 * j);
            f32x4 h = *((f32x4*)(H + (size_t)t * DM) + F.lane + 64 * j);
            h[0] += blo(ya.x) * g0 + blo(yb.x) * g1; h[1] += bhi(ya.x) * g0 + bhi(yb.x) * g1; h[2] += blo(ya.y) * g0 + blo(yb.y) * g1; h[3] += bhi(ya.y) * g0 + bhi(yb.y) * g1;
            *((f32x4*)(H + (size_t)t * DM) + F.lane + 64 * j) = h;
            u32x2 o; o.x = pk2(h[0], h[1]); o.y = pk2(h[2], h[3]);
            *((u32x2*)(HB + (size_t)t * DM) + F.lane + 64 * j) = o;
            const u32x2 ew = *((const u32x2*)(EP + (size_t)t * DM) + F.lane + 64 * j);
            ss += blo(ew.x) * blo(ew.x) + bhi(ew.x) * bhi(ew.x) + blo(ew.y) * blo(ew.y) + bhi(ew.y) * bhi(ew.y);
        }
        ss = wave_sum(ss);
        if (F.lane == 0) erstd[t] = rsqrtf(ss * (1.0f / DM) + EPS);
    }
}

#define N_PHASES (1 + 2 * 10 + 1)
#define IN(k) (lo <= (k) && (k) < hi)
#define SEAM(k) do { if (!MK_PER_PHASE && IN((k) + 1)) xcd_barrier(bar); } while (0)
template <int L>
__device__ __forceinline__ void run_layer(const Frame& F, const Params& prm, const XcdBarrier& bar, const int lo, const int hi) {
    float* H = (float*)(F.ws + WS_H);
    bf16_t* ABF = (bf16_t*)(F.ws + WS_ABF);
    const int vcu = (F.G % 8 == 0) ? (F.bid % 8) * (F.G / 8) + F.bid / 8 : F.bid;
    LAS int* cntv = (LAS int*)(F.lds + MISC_OFF + 64); LAS int* mtp = cntv + 32;
    constexpr int pb = 1 + L * 10;
    if (IN(pb + 0)) { phase_norm_bf16(F, L == 0 ? prm.in[0] : H, prm.in[3] + L * DM, ABF); SEAM(pb + 0); }
    if (IN(pb + 1)) {
        pg8::DenseSched S; S.init(ABF, F.ws + WS_WIN + L * SZ_WIN, T_TOK, DINP, DM, F.G, F.bid);
        pg8::EpiBf16 E{(bf16_t*)(F.ws + WS_P), DINP};
        pg8::gemm_phase(F.lds, DM, DM, S, E);
        SEAM(pb + 1);
    }
    if (IN(pb + 2)) { dsa_simple(F); gla_local(F, L); SEAM(pb + 2); }
    if (IN(pb + 3)) { gla_final(F, L); swa_simple(F, L); SEAM(pb + 3); }
    if (IN(pb + 4)) {
        pg8::DenseSched S; S.init(F.ws + WS_OMIX, F.ws + WS_WOUT + L * SZ_WOUT, T_TOK, DM, DM, F.G, F.bid);
        pg8::EpiResid E{L == 0 ? prm.in[0] : H, H};
        pg8::gemm_phase(F.lds, DM, DM, S, E);
        SEAM(pb + 4);
    }
    if (IN(pb + 5)) { phase_route(F, L); SEAM(pb + 5); }
    if (IN(pb + 6)) {
        moe_tables(F, L, cntv, mtp);
        pg8::MoeSched S; S.A = (const char*)ABF; S.Bt = (const char*)(F.ws + WS_WGU + L * SZ_WGU); S.list = (const int*)(F.ws + WS_LIST); S.mtp = mtp; S.cntv = cntv;
        S.K = DM; S.Kb = DM; S.G = F.G; S.c = vcu; S.gather = true; S.bstride = (size_t)1024 * DM * 2;
        pg8::EpiGateUp E{(bf16_t*)(F.ws + WS_HMID)};
        pg8::gemm_phase(F.lds, DM, DM, S, E);
        SEAM(pb + 6);
    }
    if (IN(pb + 7)) {
        moe_tables(F, L, cntv, mtp);
        { pg8::MoeSched S; S.A = (const char*)(F.ws + WS_HMID); S.Bt = (const char*)(F.ws + WS_WD + L * SZ_WD); S.list = nullptr; S.mtp = mtp; S.cntv = cntv;
          S.K = DEXP; S.Kb = DEXP; S.G = F.G; S.c = vcu; S.gather = false; S.bstride = (size_t)DM * DEXP * 2;
          pg8::EpiBf16 E{(bf16_t*)(F.ws + WS_P), DM};
          pg8::gemm_phase(F.lds, DEXP, DEXP, S, E); }
        { pg8::DenseSched S; S.init(F.ws + WS_PBF + L * SZ_PBF, F.ws + WS_WPLE + L * SZ_WPLE, T_TOK, DM, PLE_D, F.G, F.bid);
          pg8::EpiBf16 E{(bf16_t*)(F.ws + WS_EPRE), DM};
          pg8::gemm_phase(F.lds, PLE_D, PLE_D, S, E); }
        SEAM(pb + 7);
    }
    if (IN(pb + 8)) { phase_combine(F, L); SEAM(pb + 8); }
    if (IN(pb + 9)) {
        pg8::DenseSched S; S.init(ABF, F.ws + WS_WPG + L * SZ_WPG, T_TOK, DM, DM, F.G, F.bid);
        pg8::EpiPleGate E{H, (const bf16_t*)(F.ws + WS_EPRE), (const float*)(F.ws + WS_ERSTD), prm.in[19] + L * DM};
        pg8::gemm_phase(F.lds, DM, DM, S, E);
        SEAM(pb + 9);
    }
}
__global__ void __launch_bounds__(NTHREADS, 2) mk_fwd(Params prm) {
    extern __shared__ __attribute__((aligned(16))) unsigned char lds_raw[];
    Frame F; F.lds = (LAS unsigned char*)lds_raw; F.tid = threadIdx.x; F.lane = F.tid & 63; F.wave = __builtin_amdgcn_readfirstlane(F.tid >> 6);
    F.G = gridDim.x; F.bid = blockIdx.x; F.p = &prm; F.ws = prm.ws;
    volatile LAS unsigned* misc = (volatile LAS unsigned*)(F.lds + MISC_OFF);
    if (F.tid < 4) misc[F.tid] = 0u;
    __syncthreads();
    XcdBarrier bar; bar.bar = (unsigned*)(F.ws + WS_CTL) + CW_BAR; bar.x = 0; bar.st = misc;
    if (!MK_PER_PHASE) bar = xcd_barrier_post((unsigned*)(F.ws + WS_CTL) + CW_BAR, misc);
    const int lo = prm.ph_lo, hi = prm.ph_hi;
    if (IN(0)) { phase_prologue(F); SEAM(0); }
    run_layer<0>(F, prm, bar, lo, hi);
    run_layer<1>(F, prm, bar, lo, hi);
    if (IN(21)) phase_final(F, (const float*)(F.ws + WS_H), prm.in[21], prm.out);
}
#undef IN
#undef SEAM

extern "C" void kernel_launch(void* const* d_in, const int* in_sizes, int n_in, void* d_out, int out_size, void* d_ws, size_t ws_size, hipStream_t stream) {
    static int grid = 0;
    if (!grid) {
        if (n_in != 22 || ws_size < WS_END) { grid = -1; return; }
        int dev = 0, cus = 0, per_cu = 0;
        if (hipGetDevice(&dev) != hipSuccess || hipDeviceGetAttribute(&cus, hipDeviceAttributeMultiprocessorCount, dev) != hipSuccess) { grid = -1; return; }
        if (hipFuncSetAttribute((const void*)mk_fwd, hipFuncAttributeMaxDynamicSharedMemorySize, LDS_BYTES) != hipSuccess) { grid = -1; return; }
        if (hipOccupancyMaxActiveBlocksPerMultiprocessor(&per_cu, (const void*)mk_fwd, NTHREADS, LDS_BYTES) != hipSuccess || per_cu < 1) { grid = -1; return; }
        grid = cus;
        if (grid > 256) grid = 256;
    }
    if (grid < 0) return;
    (void)hipMemsetAsync((char*)d_ws + WS_CTL, 0, CTL_BYTES, stream);
    Params p{};
    for (int i = 0; i < 22; ++i) p.in[i] = (const float*)d_in[i];
    p.out = (float*)d_out; p.ws = (unsigned char*)d_ws;
#if MK_PER_PHASE
    for (int ph = 0; ph < N_PHASES; ++ph) { p.ph_lo = ph; p.ph_hi = ph + 1; hipLaunchKernelGGL(mk_fwd, dim3(grid), dim3(NTHREADS), LDS_BYTES, stream, p); }
#else
    p.ph_lo = 0; p.ph_hi = N_PHASES;
    hipLaunchKernelGGL(mk_fwd, dim3(grid), dim3(NTHREADS), LDS_BYTES, stream, p);
#endif
}
```

```cpp
#include <hip/hip_runtime.h>
#include <stdint.h>

#ifndef MK_PER_PHASE
#define MK_PER_PHASE 0
#endif

#define LAS __attribute__((address_space(3)))
typedef unsigned short bf16_t;
typedef short bf16x8 __attribute__((ext_vector_type(8)));
typedef float f32x4 __attribute__((ext_vector_type(4)));
typedef float f32x2 __attribute__((ext_vector_type(2)));
typedef unsigned u32x4 __attribute__((ext_vector_type(4)));
typedef unsigned u32x2 __attribute__((ext_vector_type(2)));

#define T_TOK 16384
#define SEQ 2048
#define DM 1024
#define DIN 2520
#define DINP 2560
#define PLE_D 256
#define NEXP 32
#define DEXP 512
#define LIST_CAP 32768
#define MOE_PROWS 40960
#define C_GQ 0
#define C_GK 128
#define C_GV 256
#define C_GG 512
#define C_GA 768
#define C_DQ 784
#define C_DK 1040
#define C_DV 1104
#define C_IQ 1168
#define C_IK 1680
#define C_IW 1744
#define C_SQ 1752
#define C_SK 2264
#define C_SV 2392
#define EPS 1e-6f
#define NTHREADS 512
#define LDS_BYTES 159744
#define MISC_OFF 147456

constexpr size_t WS_CTL = 0;
constexpr size_t CTL_BYTES = 32768;
constexpr size_t WS_WIN = WS_CTL + CTL_BYTES;
constexpr size_t SZ_WIN = (size_t)DINP * DM * 2;
constexpr size_t WS_WOUT = WS_WIN + 2 * SZ_WIN;
constexpr size_t SZ_WOUT = (size_t)DM * DM * 2;
constexpr size_t WS_WGU = WS_WOUT + 2 * SZ_WOUT;
constexpr size_t SZ_WGU = (size_t)NEXP * 1024 * DM * 2;
constexpr size_t WS_WD = WS_WGU + 2 * SZ_WGU;
constexpr size_t SZ_WD = (size_t)NEXP * DM * DEXP * 2;
constexpr size_t WS_WPLE = WS_WD + 2 * SZ_WD;
constexpr size_t SZ_WPLE = (size_t)DM * PLE_D * 2;
constexpr size_t WS_WPG = WS_WPLE + 2 * SZ_WPLE;
constexpr size_t SZ_WPG = (size_t)DM * DM * 2;
constexpr size_t WS_PBF = WS_WPG + 2 * SZ_WPG;
constexpr size_t SZ_PBF = (size_t)T_TOK * PLE_D * 2;
constexpr size_t WS_H = WS_PBF + 2 * SZ_PBF;
constexpr size_t WS_ABF = WS_H + (size_t)T_TOK * DM * 4;
constexpr size_t WS_P = WS_ABF + (size_t)T_TOK * DM * 2;
constexpr size_t WS_OMIX = WS_P + (size_t)T_TOK * DINP * 2;
constexpr size_t WS_HMID = WS_OMIX + (size_t)T_TOK * DM * 2;
constexpr size_t WS_EPRE = WS_OMIX;
constexpr size_t WS_GU = WS_HMID + (size_t)MOE_PROWS * DEXP * 2;
constexpr size_t WS_GD = WS_GU + (size_t)256 * 4 * 2048 * 4;
constexpr size_t WS_LIST = WS_GD + (size_t)256 * 128 * 4;
constexpr size_t WS_SLOT = WS_LIST + (size_t)NEXP * LIST_CAP * 4;
constexpr size_t WS_GATE = WS_SLOT + (size_t)T_TOK * 2 * 4;
constexpr size_t WS_ERSTD = WS_GATE + (size_t)T_TOK * 2 * 4;
constexpr size_t WS_VT = WS_ERSTD + (size_t)T_TOK * 4;
constexpr size_t WS_SVT = WS_VT + (size_t)8 * 64 * SEQ * 2;
constexpr size_t WS_END = WS_SVT + (size_t)8 * 128 * SEQ * 2;
#define CW_BAR 0
#define CW_CURSOR 4096

__device__ __forceinline__ float bf2f(unsigned b) { return __uint_as_float(b << 16); }
__device__ __forceinline__ unsigned pk2(float lo, float hi) { unsigned r; asm("v_cvt_pk_bf16_f32 %0, %1, %2" : "=v"(r) : "v"(lo), "v"(hi)); return r; }
__device__ __forceinline__ float blo(unsigned w) { return __uint_as_float(w << 16); }
__device__ __forceinline__ float bhi(unsigned w) { return __uint_as_float(w & 0xffff0000u); }
__device__ __forceinline__ float wave_sum(float v) {
#pragma unroll
    for (int o = 32; o > 0; o >>= 1) v += __shfl_xor(v, o);
    return v;
}
__device__ __forceinline__ float wave_max(float v) {
#pragma unroll
    for (int o = 32; o > 0; o >>= 1) v = fmaxf(v, __shfl_xor(v, o));
    return v;
}
__device__ __forceinline__ float fast_sigmoid(float x) { return __builtin_amdgcn_rcpf(1.0f + __expf(-x)); }
__device__ __forceinline__ int rel_bucket(int n) {
    if (n < 16) return n;
    const float nf = (float)n;
    int large = 16 + (int)(logf(nf / 16.0f) / 2.0794415416798357f * 16.0f);
    return large < 31 ? large : 31;
}
__device__ __forceinline__ void ld8(const bf16_t* p, float (&o)[8]) {
    const u32x4 w = *(const u32x4*)p;
    o[0] = blo(w.x); o[1] = bhi(w.x); o[2] = blo(w.y); o[3] = bhi(w.y); o[4] = blo(w.z); o[5] = bhi(w.z); o[6] = blo(w.w); o[7] = bhi(w.w);
}

#define XB_TMO      128
#define XB_XCNT(j)  (256  + 64 * (j))
#define XB_XSUB(j)  (1280 + 64 * (j))
#define XB_XGEN(j)  (2304 + 64 * (j))
#define XB_TOP      3328
#define XB_TOPGEN   3392
#define XCD_BAR_WORDS 3456
#define XB_SPIN_CAP (1u << 18)
__device__ __forceinline__ unsigned xb_ld(unsigned* p)              { return __hip_atomic_load(p, __ATOMIC_RELAXED, __HIP_MEMORY_SCOPE_AGENT); }
__device__ __forceinline__ unsigned xb_add(unsigned* p, unsigned v) { return __hip_atomic_fetch_add(p, v, __ATOMIC_RELAXED, __HIP_MEMORY_SCOPE_AGENT); }
__device__ __forceinline__ unsigned xb_xcc_id() { return (unsigned)__builtin_amdgcn_s_getreg((3 << 11) | 20) & 0xFu; }
#define XB_SPIN(cond, bar) do { unsigned _sp = 0; while (cond) { __builtin_amdgcn_s_sleep(1); \
    if ((++_sp & 255u) == 0u) { if (xb_ld(&(bar)[XB_TMO])) break; if (_sp > XB_SPIN_CAP) { atomicAdd(&(bar)[XB_TMO], 1u); break; } } } } while (0)
struct XcdBarrier { unsigned* bar; unsigned x; volatile LAS unsigned* st; };
__device__ __forceinline__ XcdBarrier xcd_barrier_post(unsigned* bar, volatile LAS unsigned* st) {
    XcdBarrier b; b.bar = bar; b.x = xb_xcc_id(); b.st = st;
    if (threadIdx.x == 0) (void)xb_add(&bar[XB_XCNT(b.x)], 1u);
    return b;
}
__device__ __forceinline__ void xcd_barrier_complete(unsigned* bar, unsigned x, unsigned& nloc, unsigned& nx) {
    const unsigned G = gridDim.x * gridDim.y * gridDim.z;
    unsigned sum, cnt, mine, sp = 0u;
    for (;;) {
        sum = 0u; cnt = 0u; mine = 0u;
#pragma unroll
        for (unsigned j = 0; j < 16; ++j) { const unsigned c = xb_ld(&bar[XB_XCNT(j)]); sum += c; cnt += (c > 0u) ? 1u : 0u; mine = (j == x) ? c : mine; }
        if (sum == G) break;
        __builtin_amdgcn_s_sleep(1);
        if ((++sp & 255u) == 0u) { if (xb_ld(&bar[XB_TMO])) break; if (sp > XB_SPIN_CAP) { atomicAdd(&bar[XB_TMO], 1u); break; } }
    }
    nloc = mine > 0u ? mine : 1u; nx = cnt > 0u ? cnt : 1u;
}
__device__ __forceinline__ void xcd_barrier(const XcdBarrier& b) {
    asm volatile("s_waitcnt vmcnt(0)" ::: "memory");
    __syncthreads();
    if (threadIdx.x == 0) {
        unsigned* bar = b.bar;
        __builtin_amdgcn_s_waitcnt(0);
        unsigned nloc = b.st[0], nx = b.st[1];
        if (nloc == 0u) { xcd_barrier_complete(bar, b.x, nloc, nx); b.st[0] = nloc; b.st[1] = nx; }
        const unsigned old = xb_add(&bar[XB_XSUB(b.x)], 1u);
        const unsigned gen = old / nloc;
        if (old + 1u == (gen + 1u) * nloc) {
            __builtin_amdgcn_fence(__ATOMIC_RELEASE, "agent");
            asm volatile("s_waitcnt vmcnt(0)" ::: "memory");
            const unsigned og = xb_add(&bar[XB_TOP], 1u);
            const unsigned tg = og / nx;
            if (og + 1u == (tg + 1u) * nx) xb_add(&bar[XB_TOPGEN], 1u);
            else XB_SPIN(xb_ld(&bar[XB_TOPGEN]) == tg, bar);
            __builtin_amdgcn_fence(__ATOMIC_ACQUIRE, "agent");
            xb_add(&bar[XB_XGEN(b.x)], 1u);
            asm volatile("s_waitcnt vmcnt(0)" ::: "memory");
        } else {
            XB_SPIN(xb_ld(&bar[XB_XGEN(b.x)]) == gen, bar);
            __builtin_amdgcn_fence(__ATOMIC_ACQUIRE, "agent");
            asm volatile("s_waitcnt vmcnt(0)" ::: "memory");
        }
    }
    __syncthreads();
}

namespace pg8 {
constexpr int BM = 256, BK = 64, HALF = 128, HTB = HALF * BK * 2, STAGE_BYTES = 8 * HTB, NXCD = 8, WGM = 8;
__host__ __device__ __forceinline__ int lds_byte(int r, int c) { const int st = (r >> 4) * 2 + (c >> 5), rr = r & 15, cc = c & 31, ob = rr * 64 + cc * 2; return st * 1024 + (ob ^ (((ob >> 9) & 1) << 5)); }
__host__ __device__ __forceinline__ void stage_rc(int b, int& R, int& C) { const int st = b / 1024, sb = b % 1024, swz = sb ^ (((sb >> 9) & 1) << 5); R = (st >> 1) * 16 + swz / 64; C = (st & 1) * 32 + (swz % 64) / 2; }
__host__ __device__ __forceinline__ int perm32(int rho) { const int n = rho >> 4, i = rho & 15; return 8 * (i >> 2) + 4 * n + (i & 3); }

struct Unit { int pn, orow, e, mt, cnt; const char* a; const char* b; };

struct DenseSched {
    const char* A; const char* Bt; int K, nM, nN, nwg, G, c;
    __device__ void init(const void* A_, const void* Bt_, int M, int N, int K_, int G_, int c_) { A = (const char*)A_; Bt = (const char*)Bt_; K = K_; nM = M / BM; nN = N / BM; nwg = nM * nN; G = G_; c = c_; }
    __device__ __forceinline__ bool next(int i, Unit& u) const {
        const long L = (long)i * G + c; if (L >= nwg) return false;
        int wgid = (int)L; { const int q = nwg / NXCD, r = nwg % NXCD, xcd = wgid % NXCD, off = wgid / NXCD; wgid = (xcd < r ? xcd * (q + 1) : r * (q + 1) + (xcd - r) * q) + off; }
        const int nig = WGM * nN, gid = wgid / nig, fm = gid * WGM, gsz = (nM - fm) < WGM ? (nM - fm) : WGM;
        const int pm = fm + ((wgid % nig) % gsz); u.pn = (wgid % nig) / gsz; u.orow = pm * BM; u.e = 0; u.mt = pm; u.cnt = BM;
        u.a = A + (size_t)pm * BM * K * 2; u.b = Bt + (size_t)u.pn * BM * K * 2; return true;
    }
    __device__ __forceinline__ void a_offs(const Unit&, const int (&R)[2], const int (&C)[2], unsigned (&aro)[2][2]) const {
#pragma unroll
        for (int h = 0; h < 2; ++h)
#pragma unroll
            for (int i = 0; i < 2; ++i) aro[h][i] = (unsigned)((h * HALF + R[i]) * K + C[i]) * 2u;
    }
};
struct MoeSched {
    const char* A; const char* Bt; const int* list; const LAS int* mtp; const LAS int* cntv; int K, Kb, G, c; bool gather; size_t bstride;
    __device__ __forceinline__ bool next(int i, Unit& u) const {
        const int L = i * G + c; const int total = mtp[NEXP] * 4; if (L >= total) return false;
        const int gm = L >> 2; u.pn = L & 3; int e = 0;
#pragma unroll 1
        for (int j = 1; j < NEXP; ++j) e += (mtp[j] <= gm) ? 1 : 0;
        u.e = e; u.mt = gm - mtp[e]; u.cnt = cntv[e]; u.orow = gm * BM;
        u.a = gather ? A : A + (size_t)gm * BM * K * 2;
        u.b = Bt + (size_t)e * bstride + (size_t)u.pn * BM * Kb * 2; return true;
    }
    __device__ __forceinline__ void a_offs(const Unit& u, const int (&R)[2], const int (&C)[2], unsigned (&aro)[2][2]) const {
#pragma unroll
        for (int h = 0; h < 2; ++h)
#pragma unroll
            for (int i = 0; i < 2; ++i) {
                if (gather) { const int pos = u.mt * BM + h * HALF + R[i]; const int tok = pos < u.cnt ? list[(size_t)u.e * LIST_CAP + pos] : 0; aro[h][i] = (unsigned)(tok * K + C[i]) * 2u; }
                else aro[h][i] = (unsigned)((h * HALF + R[i]) * K + C[i]) * 2u;
            }
    }
};

struct EpiBf16 {
    static constexpr bool PERM = true;
    bf16_t* O; int ldc;
    __device__ __forceinline__ void operator()(const f32x4 (&acc)[2][2][4][2], const Unit& u, int wr, int wc, int fr, int fq) const {
        const int row0 = u.orow + wr * 64 + fr, col0 = u.pn * BM + wc * 32 + 8 * fq;
#pragma unroll
        for (int ai = 0; ai < 2; ++ai)
#pragma unroll
            for (int m = 0; m < 4; ++m) { bf16_t* rowp = O + (size_t)(row0 + ai * HALF + m * 16) * ldc + col0;
#pragma unroll
                for (int bj = 0; bj < 2; ++bj) { const f32x4 v0 = acc[ai][bj][m][0], v1 = acc[ai][bj][m][1];
                    u32x4 w; w.x = pk2(v0[0], v0[1]); w.y = pk2(v0[2], v0[3]); w.z = pk2(v1[0], v1[1]); w.w = pk2(v1[2], v1[3]);
                    *(u32x4*)(rowp + bj * HALF) = w; } }
    }
};
struct EpiInProj {
    static constexpr bool PERM = true;
    bf16_t* O; bf16_t* VT; bf16_t* SVT;
    __device__ __forceinline__ void operator()(const f32x4 (&acc)[2][2][4][2], const Unit& u, int wr, int wc, int fr, int fq) const {
        const int row0 = u.orow + wr * 64 + fr, col0 = u.pn * BM + wc * 32 + 8 * fq;
#pragma unroll
        for (int ai = 0; ai < 2; ++ai)
#pragma unroll
            for (int m = 0; m < 4; ++m) { const int row = row0 + ai * HALF + m * 16; bf16_t* rowp = O + (size_t)row * DINP + col0;
#pragma unroll
                for (int bj = 0; bj < 2; ++bj) { const f32x4 v0 = acc[ai][bj][m][0], v1 = acc[ai][bj][m][1];
                    u32x4 w; w.x = pk2(v0[0], v0[1]); w.y = pk2(v0[2], v0[3]); w.z = pk2(v1[0], v1[1]); w.w = pk2(v1[2], v1[3]);
                    *(u32x4*)(rowp + bj * HALF) = w;
                    const int c = col0 + bj * HALF;
                    bf16_t* tp = nullptr;
                    if (c >= C_DV && c < C_DV + 64) tp = VT + ((size_t)(row >> 11) * 64 + (c - C_DV)) * SEQ + (row & (SEQ - 1));
                    else if (c >= C_SV && c < C_SV + 128) tp = SVT + ((size_t)(row >> 11) * 128 + (c - C_SV)) * SEQ + (row & (SEQ - 1));
                    if (tp) { tp[0] = (bf16_t)(w.x & 0xffffu); tp[SEQ] = (bf16_t)(w.x >> 16); tp[2 * SEQ] = (bf16_t)(w.y & 0xffffu); tp[3 * SEQ] = (bf16_t)(w.y >> 16);
                              tp[4 * SEQ] = (bf16_t)(w.z & 0xffffu); tp[5 * SEQ] = (bf16_t)(w.z >> 16); tp[6 * SEQ] = (bf16_t)(w.w & 0xffffu); tp[7 * SEQ] = (bf16_t)(w.w >> 16); } } }
    }
};
struct EpiGateUp {
    static constexpr bool PERM = true;
    bf16_t* O;
    __device__ __forceinline__ void operator()(const f32x4 (&acc)[2][2][4][2], const Unit& u, int wr, int wc, int fr, int fq) const {
        const int row0 = u.orow + wr * 64 + fr, col0 = (u.pn * BM + wc * 32 + 8 * fq) >> 1;
#pragma unroll
        for (int ai = 0; ai < 2; ++ai)
#pragma unroll
            for (int m = 0; m < 4; ++m) { bf16_t* rowp = O + (size_t)(row0 + ai * HALF + m * 16) * DEXP + col0;
#pragma unroll
                for (int bj = 0; bj < 2; ++bj) { const f32x4 v0 = acc[ai][bj][m][0], v1 = acc[ai][bj][m][1];
                    const float h0 = v0[0] * fast_sigmoid(v0[0]) * v0[1], h1 = v0[2] * fast_sigmoid(v0[2]) * v0[3];
                    const float h2 = v1[0] * fast_sigmoid(v1[0]) * v1[1], h3 = v1[2] * fast_sigmoid(v1[2]) * v1[3];
                    u32x2 w; w.x = pk2(h0, h1); w.y = pk2(h2, h3);
                    *(u32x2*)(rowp + bj * (HALF / 2)) = w; } }
    }
};
struct EpiResid {
    static constexpr bool PERM = false;
    const float* R; float* C;
    __device__ __forceinline__ void operator()(const f32x4 (&acc)[2][2][4][2], const Unit& u, int wr, int wc, int fr, int fq) const {
        const int row0 = u.orow + wr * 64 + fr, col0 = u.pn * BM + wc * 32 + 4 * fq;
#pragma unroll
        for (int ai = 0; ai < 2; ++ai)
#pragma unroll
            for (int m = 0; m < 4; ++m) { const size_t ro = (size_t)(row0 + ai * HALF + m * 16) * DM + col0;
#pragma unroll
                for (int bj = 0; bj < 2; ++bj)
#pragma unroll
                    for (int n = 0; n < 2; ++n) { const size_t o = ro + bj * HALF + n * 16; const f32x4 r = *(const f32x4*)(R + o); *(f32x4*)(C + o) = r + acc[ai][bj][m][n]; } }
    }
};
struct EpiPleGate {
    static constexpr bool PERM = false;
    float* H; const bf16_t* E; const float* erstd; const float* g;
    __device__ __forceinline__ void operator()(const f32x4 (&acc)[2][2][4][2], const Unit& u, int wr, int wc, int fr, int fq) const {
        const int row0 = u.orow + wr * 64 + fr, col0 = u.pn * BM + wc * 32 + 4 * fq;
        f32x4 gv[2][2];
#pragma unroll
        for (int bj = 0; bj < 2; ++bj)
#pragma unroll
            for (int n = 0; n < 2; ++n) gv[bj][n] = *(const f32x4*)(g + col0 + bj * HALF + n * 16);
#pragma unroll
        for (int ai = 0; ai < 2; ++ai)
#pragma unroll
            for (int m = 0; m < 4; ++m) { const int row = row0 + ai * HALF + m * 16; const size_t ro = (size_t)row * DM + col0; const float rs = erstd[row];
#pragma unroll
                for (int bj = 0; bj < 2; ++bj)
#pragma unroll
                    for (int n = 0; n < 2; ++n) { const size_t o = ro + bj * HALF + n * 16; const f32x4 h = *(const f32x4*)(H + o); const u32x2 ew = *(const u32x2*)(E + o); const f32x4 a = acc[ai][bj][m][n];
                        f32x4 r; r[0] = h[0] + blo(ew.x) * rs * gv[bj][n][0] * fast_sigmoid(a[0]); r[1] = h[1] + bhi(ew.x) * rs * gv[bj][n][1] * fast_sigmoid(a[1]);
                        r[2] = h[2] + blo(ew.y) * rs * gv[bj][n][2] * fast_sigmoid(a[2]); r[3] = h[3] + bhi(ew.y) * rs * gv[bj][n][3] * fast_sigmoid(a[3]);
                        *(f32x4*)(H + o) = r; } }
    }
};

template <class Epi, class Sched>
__device__ __forceinline__ void gemm_phase(LAS unsigned char* lds, const int K, const int Kb  , const Sched& S, const Epi& E) {
    int tid_ = threadIdx.x; asm volatile("" : "+v"(tid_));
    const int tid = tid_, wid = __builtin_amdgcn_readfirstlane(tid >> 6), lane = tid & 63, wr = wid >> 2, wc = wid & 3, fr = lane & 15, fq = lane >> 4;
    const int nt = K / BK;
    int Rr[2], Cc[2]; unsigned voffB[2];
#pragma unroll
    for (int i = 0; i < 2; ++i) { int R, C; stage_rc(tid * 16 + i * 8192, R, C); const int Rb = Epi::PERM ? ((R & ~31) + perm32(R & 31)) : R; Rr[i] = R; Cc[i] = C; voffB[i] = (unsigned)(Rb * Kb + C) * 2u; }
    const size_t kstep = (size_t)(BK * 2);
    const size_t hstepB = (size_t)HALF * Kb * 2;
    const unsigned ldsw = (unsigned)wid * 1024u;
    const int aoff = lds_byte(wr * 64 + fr, fq * 8), boff = lds_byte(wc * 32 + fr, fq * 8);
#define PG8_SA(b, h) (((b) * 2 + (h)) * HTB)
#define PG8_SB(b, h) ((4 + (b) * 2 + (h)) * HTB)
#define PG8_STAGE_B(bufoff, gbase) do { _Pragma("unroll") for (int _i = 0; _i < 2; ++_i) \
        __builtin_amdgcn_global_load_lds((const unsigned*)((const char*)(gbase) + voffB[_i]), (LAS unsigned*)(lds + (bufoff) + ldsw + _i * 8192), 16, 0, 0); } while (0)
#define PG8_STAGE_A(bufoff, gbase, o0, o1) do { \
        __builtin_amdgcn_global_load_lds((const unsigned*)((const char*)(gbase) + (o0)), (LAS unsigned*)(lds + (bufoff) + ldsw), 16, 0, 0); \
        __builtin_amdgcn_global_load_lds((const unsigned*)((const char*)(gbase) + (o1)), (LAS unsigned*)(lds + (bufoff) + ldsw + 8192), 16, 0, 0); } while (0)
#define PG8_LDA(dst, b, h) do { _Pragma("unroll") for (int m = 0; m < 4; ++m) _Pragma("unroll") for (int k = 0; k < 2; ++k) dst[m][k] = *(const LAS bf16x8*)(lds + PG8_SA(b, h) + aoff + m * 2048 + k * 1024); } while (0)
#define PG8_LDB(dst, b, h) do { _Pragma("unroll") for (int n = 0; n < 2; ++n) _Pragma("unroll") for (int k = 0; k < 2; ++k) dst[n][k] = *(const LAS bf16x8*)(lds + PG8_SB(b, h) + boff + n * 2048 + k * 1024); } while (0)
#define PG8_MMA(ai, bj, At, Bt) do { __builtin_amdgcn_s_setprio(1); _Pragma("unroll") for (int m = 0; m < 4; ++m) _Pragma("unroll") for (int n = 0; n < 2; ++n) _Pragma("unroll") for (int k = 0; k < 2; ++k) \
        acc[ai][bj][m][n] = __builtin_amdgcn_mfma_f32_16x16x32_bf16(Bt[n][k], At[m][k], acc[ai][bj][m][n], 0, 0, 0); __builtin_amdgcn_s_setprio(0); } while (0)
#define PG8_WAIT_V(n) asm volatile("s_waitcnt vmcnt(" #n ")" ::: "memory")
#define PG8_WAIT_L(n) asm volatile("s_waitcnt lgkmcnt(" #n ")" ::: "memory")
#define PG8_BAR __builtin_amdgcn_s_barrier()
#define PG8_SCHED __builtin_amdgcn_sched_barrier(0)
    Unit cur, nxt; int ui = 0;
    if (!S.next(0, cur)) return;
    f32x4 acc[2][2][4][2];
#pragma unroll
    for (int a = 0; a < 2; ++a)
#pragma unroll
        for (int b = 0; b < 2; ++b)
#pragma unroll
            for (int m = 0; m < 4; ++m)
#pragma unroll
                for (int n = 0; n < 2; ++n) acc[a][b][m][n] = (f32x4){0.f, 0.f, 0.f, 0.f};
    bf16x8 At[4][2], B0[2][2], B1[2][2];
    unsigned aroC[2][2], aroN[2][2];
    S.a_offs(cur, Rr, Cc, aroC);
    const char* cA = cur.a; const char* cB = cur.b;
    PG8_STAGE_B(PG8_SB(0, 0), cB); PG8_STAGE_A(PG8_SA(0, 0), cA, aroC[0][0], aroC[0][1]); PG8_STAGE_B(PG8_SB(0, 1), cB + hstepB); PG8_STAGE_A(PG8_SA(0, 1), cA, aroC[1][0], aroC[1][1]);
    if (wr == 1) PG8_BAR;
    PG8_WAIT_V(4); PG8_BAR;
    PG8_STAGE_B(PG8_SB(1, 0), cB + kstep); PG8_STAGE_A(PG8_SA(1, 0), cA + kstep, aroC[0][0], aroC[0][1]); PG8_STAGE_B(PG8_SB(1, 1), cB + hstepB + kstep);
    PG8_WAIT_V(6); PG8_BAR;
    for (;;) {
        const bool has_next = S.next(ui + 1, nxt);
        if (has_next) S.a_offs(nxt, Rr, Cc, aroN);
        else {
#pragma unroll
            for (int h = 0; h < 2; ++h)
#pragma unroll
                for (int i = 0; i < 2; ++i) aroN[h][i] = aroC[h][i];
        }
        const char* nA = has_next ? nxt.a : cA; const char* nB = has_next ? nxt.b : cB;
        for (int t = 0; t < nt; t += 2) {
            const bool last = (t == nt - 2);
            const char* a1 = cA + (size_t)(t + 1) * kstep;
            const char* a2 = last ? nA : cA + (size_t)(t + 2) * kstep; const char* b2 = last ? nB : cB + (size_t)(t + 2) * kstep;
            const char* a3 = a2 + kstep; const char* b3 = b2 + kstep;
            const unsigned x00 = last ? aroN[0][0] : aroC[0][0], x01 = last ? aroN[0][1] : aroC[0][1], x10 = last ? aroN[1][0] : aroC[1][0], x11 = last ? aroN[1][1] : aroC[1][1];
            PG8_LDB(B0, 0, 0); PG8_SCHED; PG8_LDA(At, 0, 0); PG8_STAGE_A(PG8_SA(1, 1), a1, aroC[1][0], aroC[1][1]);
            PG8_WAIT_L(8); PG8_BAR; PG8_WAIT_L(0); PG8_MMA(0, 0, At, B0); PG8_BAR; PG8_SCHED;
            PG8_LDB(B1, 0, 1); PG8_STAGE_B(PG8_SB(0, 0), b2);
            PG8_BAR; PG8_WAIT_L(0); PG8_MMA(0, 1, At, B1); PG8_BAR;
            PG8_LDA(At, 0, 1); PG8_STAGE_A(PG8_SA(0, 0), a2, x00, x01);
            PG8_BAR; PG8_WAIT_L(0); PG8_MMA(1, 0, At, B0); PG8_BAR; PG8_SCHED;
            PG8_STAGE_B(PG8_SB(0, 1), b2 + hstepB);
            PG8_WAIT_V(6); PG8_BAR; PG8_MMA(1, 1, At, B1); PG8_BAR;
            PG8_LDB(B0, 1, 0); PG8_SCHED; PG8_LDA(At, 1, 0); PG8_STAGE_A(PG8_SA(0, 1), a2, x10, x11);
            PG8_WAIT_L(8); PG8_BAR; PG8_WAIT_L(0); PG8_MMA(0, 0, At, B0); PG8_BAR; PG8_SCHED;
            PG8_LDB(B1, 1, 1); PG8_STAGE_B(PG8_SB(1, 0), b3);
            PG8_BAR; PG8_WAIT_L(0); PG8_MMA(0, 1, At, B1); PG8_BAR;
            PG8_LDA(At, 1, 1); PG8_STAGE_A(PG8_SA(1, 0), a3, x00, x01);
            PG8_BAR; PG8_WAIT_L(0); PG8_MMA(1, 0, At, B0); PG8_BAR; PG8_SCHED;
            PG8_STAGE_B(PG8_SB(1, 1), b3 + hstepB);
            PG8_WAIT_V(6); PG8_BAR; PG8_MMA(1, 1, At, B1); PG8_BAR;
        }
        E(acc, cur, wr, wc, fr, fq);
        if (!has_next) break;
#pragma unroll
        for (int a = 0; a < 2; ++a)
#pragma unroll
            for (int b = 0; b < 2; ++b)
#pragma unroll
                for (int m = 0; m < 4; ++m)
#pragma unroll
                    for (int n = 0; n < 2; ++n) acc[a][b][m][n] = (f32x4){0.f, 0.f, 0.f, 0.f};
        cur = nxt; cA = nA; cB = nB; ++ui;
#pragma unroll
        for (int h = 0; h < 2; ++h)
#pragma unroll
            for (int i = 0; i < 2; ++i) aroC[h][i] = aroN[h][i];
    }
    PG8_WAIT_V(0);
    if (wr == 0) PG8_BAR;
    PG8_BAR;
#undef PG8_SA
#undef PG8_SB
#undef PG8_STAGE_A
#undef PG8_STAGE_B
#undef PG8_LDA
#undef PG8_LDB
#undef PG8_MMA
#undef PG8_WAIT_V
#undef PG8_WAIT_L
#undef PG8_BAR
#undef PG8_SCHED
}
}

struct Params { const float* in[22]; float* out; unsigned char* ws; int ph_lo, ph_hi; };
struct Frame {
    LAS unsigned char* lds; int tid, lane, wave, G, bid;
    const Params* p; unsigned char* ws;
};
__device__ __forceinline__ Frame reframe(const Frame& F0) {
    Frame F = F0; int t = threadIdx.x; asm volatile("" : "+v"(t)); F.tid = t; F.lane = t & 63; F.wave = __builtin_amdgcn_readfirstlane(t >> 6); return F;
}

__device__ __forceinline__ void tr_item(const float* W, int K, int N, bf16_t* WT, int rmul, int radd, LAS float* scr, int item, int lane) {
    const int nblk = (N + 31) / 32, kb = item / nblk, nb = item % nblk, k0 = 64 * kb, n0 = 32 * nb;
    const int nn = n0 + (lane & 31); const bool ok = nn < N;
#pragma unroll 8
    for (int i = 0; i < 32; ++i) { const int kk = 2 * i + (lane >> 5); float v = 0.f; if (ok) v = W[(size_t)(k0 + kk) * N + nn]; scr[kk * 33 + (lane & 31)] = v; }
    asm volatile("s_waitcnt lgkmcnt(0)" ::: "memory");
    const int c = lane & 7;
#pragma unroll
    for (int j = 0; j < 4; ++j) { const int n = (lane >> 3) + 8 * j; const LAS float* s = scr + (8 * c) * 33 + n;
        u32x4 o; o.x = pk2(s[0 * 33], s[1 * 33]); o.y = pk2(s[2 * 33], s[3 * 33]); o.z = pk2(s[4 * 33], s[5 * 33]); o.w = pk2(s[6 * 33], s[7 * 33]);
        *(u32x4*)(WT + (size_t)((n0 + n) * rmul + radd) * K + k0 + 8 * c) = o; }
    asm volatile("s_waitcnt lgkmcnt(0)" ::: "memory");
}
__device__ __forceinline__ void phase_prologue(const Frame& F0) {
    const Frame F = reframe(F0);
    LAS float* scr = (LAS float*)(F.lds + F.wave * 16384);
    const int gw = F.bid * 8 + F.wave, NGW = F.G * 8;
    constexpr int I_IN = 16 * 79, I_OUT = 16 * 32, I_G = 16 * 16, I_D = 8 * 32, I_PLE = 4 * 32, I_PG = 16 * 32;
    constexpr int PER_L = I_IN + I_OUT + NEXP * 2 * I_G + NEXP * I_D + I_PLE + I_PG;
    for (int it = gw; it < 2 * PER_L; it += NGW) {
        const int L = it / PER_L; int r = it % PER_L;
        if (r < I_IN) { tr_item(F.p->in[4] + (size_t)L * DM * DIN, DM, DIN, (bf16_t*)(F.ws + WS_WIN + L * SZ_WIN), 1, 0, scr, r, F.lane); continue; } r -= I_IN;
        if (r < I_OUT) { tr_item(F.p->in[9] + (size_t)L * DM * DM, DM, DM, (bf16_t*)(F.ws + WS_WOUT + L * SZ_WOUT), 1, 0, scr, r, F.lane); continue; } r -= I_OUT;
        if (r < NEXP * 2 * I_G) { const int e = r / (2 * I_G), w = (r / I_G) & 1, q = r % I_G;
            tr_item(F.p->in[15 + w] + ((size_t)L * NEXP + e) * DM * DEXP, DM, DEXP, (bf16_t*)(F.ws + WS_WGU + L * SZ_WGU) + (size_t)e * 1024 * DM, 2, w, scr, q, F.lane); continue; } r -= NEXP * 2 * I_G;
        if (r < NEXP * I_D) { const int e = r / I_D, q = r % I_D;
            tr_item(F.p->in[17] + ((size_t)L * NEXP + e) * DEXP * DM, DEXP, DM, (bf16_t*)(F.ws + WS_WD + L * SZ_WD) + (size_t)e * DM * DEXP, 1, 0, scr, q, F.lane); continue; } r -= NEXP * I_D;
        if (r < I_PLE) { tr_item(F.p->in[18] + (size_t)L * PLE_D * DM, PLE_D, DM, (bf16_t*)(F.ws + WS_WPLE + L * SZ_WPLE), 1, 0, scr, r, F.lane); continue; } r -= I_PLE;
        tr_item(F.p->in[20] + (size_t)L * DM * DM, DM, DM, (bf16_t*)(F.ws + WS_WPG + L * SZ_WPG), 1, 0, scr, r, F.lane);
    }
    const float* pin = F.p->in[1]; bf16_t* pbf = (bf16_t*)(F.ws + WS_PBF);
    const size_t n8 = (size_t)2 * T_TOK * PLE_D / 8;
    for (size_t i = (size_t)F.bid * NTHREADS + F.tid; i < n8; i += (size_t)F.G * NTHREADS) {
        const f32x4 a = *(const f32x4*)(pin + i * 8), b = *(const f32x4*)(pin + i * 8 + 4);
        u32x4 o; o.x = pk2(a[0], a[1]); o.y = pk2(a[2], a[3]); o.z = pk2(b[0], b[1]); o.w = pk2(b[2], b[3]);
        *(u32x4*)(pbf + i * 8) = o;
    }
}

__device__ __forceinline__ void phase_norm_bf16(const Frame& F0, const float* X, const float* g, bf16_t* Y) {
    const Frame F = reframe(F0);
    const int gw = F.bid * 8 + F.wave, NGW = F.G * 8;
    f32x4 gv[4];
#pragma unroll
    for (int j = 0; j < 4; ++j) gv[j] = *(const f32x4*)(g + 4 * F.lane + 256 * j);
    for (int row = gw; row < T_TOK; row += NGW) {
        const f32x4* xr = (const f32x4*)(X + (size_t)row * DM) + F.lane;
        f32x4 v[4]; float s = 0.f;
#pragma unroll
        for (int j = 0; j < 4; ++j) { v[j] = xr[64 * j]; s += v[j][0] * v[j][0] + v[j][1] * v[j][1] + v[j][2] * v[j][2] + v[j][3] * v[j][3]; }
        const float r = rsqrtf(wave_sum(s) * (1.0f / DM) + EPS);
        u32x2* o8 = (u32x2*)(Y + (size_t)row * DM) + F.lane;
#pragma unroll
        for (int j = 0; j < 4; ++j) { u32x2 o; o.x = pk2(v[j][0] * r * gv[j][0], v[j][1] * r * gv[j][1]); o.y = pk2(v[j][2] * r * gv[j][2], v[j][3] * r * gv[j][3]); o8[64 * j] = o; }
    }
}
__device__ __forceinline__ void phase_final(const Frame& F0, const float* X, const float* g, float* Y) {
    const Frame F = reframe(F0);
    const int gw = F.bid * 8 + F.wave, NGW = F.G * 8;
    f32x4 gv[4];
#pragma unroll
    for (int j = 0; j < 4; ++j) gv[j] = *(const f32x4*)(g + 4 * F.lane + 256 * j);
    for (int row = gw; row < T_TOK; row += NGW) {
        const f32x4* xr = (const f32x4*)(X + (size_t)row * DM) + F.lane;
        f32x4 v[4]; float s = 0.f;
#pragma unroll
        for (int j = 0; j < 4; ++j) { v[j] = xr[64 * j]; s += v[j][0] * v[j][0] + v[j][1] * v[j][1] + v[j][2] * v[j][2] + v[j][3] * v[j][3]; }
        const float r = rsqrtf(wave_sum(s) * (1.0f / DM) + EPS);
        f32x4* o = (f32x4*)(Y + (size_t)row * DM) + F.lane;
#pragma unroll
        for (int j = 0; j < 4; ++j) { f32x4 w; w[0] = v[j][0] * r * gv[j][0]; w[1] = v[j][1] * r * gv[j][1]; w[2] = v[j][2] * r * gv[j][2]; w[3] = v[j][3] * r * gv[j][3]; o[64 * j] = w; }
    }
}

__device__ __forceinline__ void gla_cumdecay(const Frame& F, const bf16_t* P, int tile, const float* wa, const float* ba, LAS float* bq, LAS float* tmp  ) {
    LAS float* ga = tmp; LAS float* was = tmp + 1024; LAS float* bas = tmp + 1024 + 2048;
    for (int i = F.tid; i < 1024; i += NTHREADS) { const int t = i >> 4, r = i & 15; ga[i] = bf2f(P[(size_t)(tile * 64 + t) * DINP + C_GA + r]); }
    for (int i = F.tid; i < 2048; i += NTHREADS) was[i] = wa[i];
    if (F.tid < 128) bas[F.tid] = ba[F.tid];
    __syncthreads();
#pragma unroll 4
    for (int i = 0; i < 16; ++i) {
        const int idx = F.tid + NTHREADS * i, t = idx >> 7, j = idx & 127;
        float x = 0.f;
#pragma unroll
        for (int r = 0; r < 16; ++r) x += ga[t * 16 + r] * was[r * 128 + j];
        x += bas[j];
        const float ls = fminf(x, 0.f) - log1pf(expf(-fabsf(x)));
        bq[idx] = ls * (1.0f / 16.0f);
    }
    __syncthreads();
    if (F.tid < 128) { float run = 0.f; for (int t = 0; t < 64; ++t) { run += bq[t * 128 + F.tid]; bq[t * 128 + F.tid] = run; } }
    __syncthreads();
}
__device__ __forceinline__ void gla_local(const Frame& F0, int L) {
    const Frame F = reframe(F0);
    const bf16_t* P = (const bf16_t*)(F.ws + WS_P);
    float* GU = (float*)(F.ws + WS_GU); float* GD = (float*)(F.ws + WS_GD);
    LAS float* bq = (LAS float*)F.lds;
    LAS float* kk = bq + 8192;
    LAS float* vv = kk + 8192;
    LAS float* tmp = vv + 16384;
    for (int tile = F.bid; tile < 256; tile += F.G) {
        __syncthreads();
        gla_cumdecay(F, P, tile, F.p->in[5] + L * 2048, F.p->in[6] + L * 128, bq, tmp);
        for (int c = F.tid; c < 1024; c += NTHREADS) { const int s = c >> 4, j8 = (c & 15) * 8; float f[8]; ld8(P + (size_t)(tile * 64 + s) * DINP + C_GK + j8, f);
#pragma unroll
            for (int q = 0; q < 8; ++q) kk[s * 128 + j8 + q] = f[q] * expf(bq[63 * 128 + j8 + q] - bq[s * 128 + j8 + q]); }
        for (int c = F.tid; c < 2048; c += NTHREADS) { const int s = c >> 5, j8 = (c & 31) * 8; float f[8]; ld8(P + (size_t)(tile * 64 + s) * DINP + C_GV + j8, f);
#pragma unroll
            for (int q = 0; q < 8; ++q) vv[s * 256 + j8 + q] = f[q]; }
        __syncthreads();
        const int vq = F.tid & 15, kq = (F.tid >> 4) & 7, h = F.tid >> 7;
        f32x4 u[4];
#pragma unroll
        for (int i = 0; i < 4; ++i) u[i] = (f32x4){0.f, 0.f, 0.f, 0.f};
        for (int s = 0; s < 64; ++s) {
            const f32x4 kv = *(const LAS f32x4*)(kk + s * 128 + h * 32 + kq * 4);
            const f32x4 v4 = *(const LAS f32x4*)(vv + s * 256 + h * 64 + vq * 4);
#pragma unroll
            for (int i = 0; i < 4; ++i) u[i] += kv[i] * v4;
        }
        float* up = GU + ((size_t)tile * 4 + h) * 2048 + (kq * 4) * 64 + vq * 4;
#pragma unroll
        for (int i = 0; i < 4; ++i) *(f32x4*)(up + i * 64) = u[i];
        if (F.tid < 128) GD[(size_t)tile * 128 + F.tid] = expf(bq[63 * 128 + F.tid]);
    }
}
__device__ __forceinline__ void gla_final(const Frame& F0, int L) {
    const Frame F = reframe(F0);
    const bf16_t* P = (const bf16_t*)(F.ws + WS_P);
    const float* GU = (const float*)(F.ws + WS_GU); const float* GD = (const float*)(F.ws + WS_GD);
    bf16_t* OM = (bf16_t*)(F.ws + WS_OMIX);
    const float* gnorm = F.p->in[7] + L * 64;
    LAS float* bq = (LAS float*)F.lds;
    LAS float* qtT = bq + 8192;
    LAS float* ktT = qtT + 2048;
    LAS float* vs = ktT + 2048;
    LAS float* Ss = vs + 4096;
    LAS float* AT = Ss + 2048;
    LAS float* tmp = AT + 4096;
    for (int tile = F.bid; tile < 256; tile += F.G) {
        __syncthreads();
        gla_cumdecay(F, P, tile, F.p->in[5] + L * 2048, F.p->in[6] + L * 128, bq, tmp);
        const int cb = tile & 31, tile0 = tile - cb;
        for (int h = 0; h < 4; ++h) {
            { const int e4 = F.tid * 4, k = e4 >> 6; f32x4 S = (f32x4){0.f, 0.f, 0.f, 0.f};
              for (int c = 0; c < cb; ++c) { const float d = GD[(size_t)(tile0 + c) * 128 + h * 32 + k]; const f32x4 u = *(const f32x4*)(GU + ((size_t)(tile0 + c) * 4 + h) * 2048 + e4); S = S * d + u; }
              *(LAS f32x4*)(Ss + e4) = S; }
            { const int t = F.tid >> 3, k4 = (F.tid & 7) * 4;
              const u32x2 qw = *(const u32x2*)(P + (size_t)(tile * 64 + t) * DINP + C_GQ + h * 32 + k4);
              const u32x2 kw = *(const u32x2*)(P + (size_t)(tile * 64 + t) * DINP + C_GK + h * 32 + k4);
              const float qf[4] = {blo(qw.x), bhi(qw.x), blo(qw.y), bhi(qw.y)}, kf[4] = {blo(kw.x), bhi(kw.x), blo(kw.y), bhi(kw.y)};
#pragma unroll
              for (int q = 0; q < 4; ++q) { const float bb = bq[t * 128 + h * 32 + k4 + q]; qtT[(k4 + q) * 64 + t] = qf[q] * 0.17677669529663687f * expf(bb); ktT[(k4 + q) * 64 + t] = kf[q] * expf(-bb); } }
            { const int s = F.tid >> 3, j8 = (F.tid & 7) * 8; float f[8]; ld8(P + (size_t)(tile * 64 + s) * DINP + C_GV + h * 64 + j8, f);
#pragma unroll
              for (int q = 0; q < 8; ++q) vs[s * 64 + j8 + q] = f[q]; }
            __syncthreads();
            const int tq = F.tid >> 4, xq = F.tid & 15;
            { f32x4 a0 = (f32x4){0.f, 0.f, 0.f, 0.f}, a1 = a0;
              for (int k = 0; k < 32; ++k) { const f32x2 q2 = *(const LAS f32x2*)(qtT + k * 64 + 2 * tq); const f32x4 k4 = *(const LAS f32x4*)(ktT + k * 64 + 4 * xq); a0 += q2[0] * k4; a1 += q2[1] * k4; }
#pragma unroll
              for (int j = 0; j < 4; ++j) { const int s = 4 * xq + j; f32x2 w; w[0] = (s <= 2 * tq) ? a0[j] : 0.f; w[1] = (s <= 2 * tq + 1) ? a1[j] : 0.f; *(LAS f32x2*)(AT + s * 64 + 2 * tq) = w; } }
            __syncthreads();
            { f32x4 o0 = (f32x4){0.f, 0.f, 0.f, 0.f}, o1 = o0;
              for (int k = 0; k < 32; ++k) { const f32x2 q2 = *(const LAS f32x2*)(qtT + k * 64 + 2 * tq); const f32x4 s4 = *(const LAS f32x4*)(Ss + k * 64 + 4 * xq); o0 += q2[0] * s4; o1 += q2[1] * s4; }
              for (int s = 0; s < 64; ++s) { const f32x2 a2 = *(const LAS f32x2*)(AT + s * 64 + 2 * tq); const f32x4 v4 = *(const LAS f32x4*)(vs + s * 64 + 4 * xq); o0 += a2[0] * v4; o1 += a2[1] * v4; }
              float s0 = o0[0] * o0[0] + o0[1] * o0[1] + o0[2] * o0[2] + o0[3] * o0[3], s1 = o1[0] * o1[0] + o1[1] * o1[1] + o1[2] * o1[2] + o1[3] * o1[3];
#pragma unroll
              for (int o = 1; o < 16; o <<= 1) { s0 += __shfl_xor(s0, o); s1 += __shfl_xor(s1, o); }
              const float r0 = rsqrtf(s0 * (1.0f / 64.0f) + EPS), r1 = rsqrtf(s1 * (1.0f / 64.0f) + EPS);
              const f32x4 gn = *(const f32x4*)(gnorm + 4 * xq);
#pragma unroll
              for (int rr = 0; rr < 2; ++rr) { const int t = 2 * tq + rr; const size_t row = (size_t)(tile * 64 + t);
                  const u32x2 gw = *(const u32x2*)(P + row * DINP + C_GG + h * 64 + 4 * xq);
                  const float gg[4] = {blo(gw.x), bhi(gw.x), blo(gw.y), bhi(gw.y)};
                  const f32x4 ov = rr ? o1 : o0; const float rs = rr ? r1 : r0;
                  float w[4];
#pragma unroll
                  for (int j = 0; j < 4; ++j) w[j] = ov[j] * rs * gn[j] * (gg[j] * fast_sigmoid(gg[j]));
                  u32x2 o; o.x = pk2(w[0], w[1]); o.y = pk2(w[2], w[3]);
                  *(u32x2*)(OM + row * DM + h * 64 + 4 * xq) = o; } }
            __syncthreads();
        }
    }
}

__device__ __forceinline__ int half_sum_i(int v, LAS int* red  , int hf, int w4) {
#pragma unroll
    for (int o = 32; o > 0; o >>= 1) v += __shfl_xor(v, o);
    __syncthreads();
    if ((threadIdx.x & 63) == 0) red[hf * 4 + w4] = v;
    __syncthreads();
    return red[hf * 4] + red[hf * 4 + 1] + red[hf * 4 + 2] + red[hf * 4 + 3];
}
__device__ __forceinline__ void dsa_simple(const Frame& F0) {
    const Frame F = reframe(F0);
    const bf16_t* P = (const bf16_t*)(F.ws + WS_P);
    bf16_t* OM = (bf16_t*)(F.ws + WS_OMIX);
    const float* rel_bias = F.p->in[2];
    const int hf = F.tid >> 8, tid = F.tid & 255, w4 = tid >> 6;
    LAS float* base = (LAS float*)(F.lds + hf * 49152);
    LAS float* qi = base;
    LAS float* qd = base + 512;
    LAS float* wq = base + 768;
    LAS float* lg = base + 1024;
    LAS unsigned* kl = (LAS unsigned*)(base + 1024 + 8192);
    LAS float* redf = base + 1024 + 8192 + 2048;
    LAS int* red = (LAS int*)(F.lds + 2 * 49152);
    for (int tile = F.bid; tile < 256; tile += F.G) {
#pragma unroll 1
        for (int it = 0; it < 32; ++it) {
            const int tg = tile * 64 + it * 2 + hf, b = tg / SEQ, t = tg % SEQ;
            __syncthreads();
            const bf16_t* pr = P + (size_t)tg * DINP;
            qi[tid] = bf2f(pr[C_IQ + tid]); qi[tid + 256] = bf2f(pr[C_IQ + 256 + tid]);
            qd[tid] = bf2f(pr[C_DQ + tid]) * 0.125f;
            if (tid < 8) wq[tid] = bf2f(pr[C_IW + tid]) * 0.04419417382415922f;
            __syncthreads();
#pragma unroll 1
            for (int i = 0; i < 8; ++i) {
                const int s = tid + 256 * i;
                unsigned key = 0u;
                if (s <= t) {
                    const bf16_t* kr = P + (size_t)(b * SEQ + s) * DINP + C_IK;
                    float sc = 0.f;
#pragma unroll 1
                    for (int h = 0; h < 8; ++h) {
                        float acc = 0.f;
#pragma unroll 2
                        for (int d = 0; d < 64; d += 8) {
                            float kv[8]; ld8(kr + d, kv);
#pragma unroll
                            for (int q = 0; q < 8; ++q) acc += qi[h * 64 + d + q] * kv[q];
                        }
                        sc += wq[h] * fmaxf(acc, 0.f);
                    }
                    sc += 0.0f;
                    const unsigned u = __float_as_uint(sc);
                    key = (u & 0x80000000u) ? ~u : (u | 0x80000000u);
                }
                kl[s] = key;
            }
            unsigned K = 0u;
#pragma unroll 1
            for (int bit = 31; bit >= 0; --bit) {
                const unsigned cand = K | (1u << bit);
                int c = 0;
#pragma unroll 1
                for (int i = 0; i < 8; ++i) c += (kl[tid + 256 * i] >= cand) ? 1 : 0;
                if (half_sum_i(c, red, hf, w4) >= 256) K = cand;
            }
            int cg = 0;
#pragma unroll 1
            for (int i = 0; i < 8; ++i) cg += (kl[tid + 256 * i] > K) ? 1 : 0;
            const int r = 256 - half_sum_i(cg, red, hf, w4);
            int lo = 0, hi = SEQ - 1;
#pragma unroll 1
            for (int itb = 0; itb < 11; ++itb) {
                const int mid = (lo + hi) >> 1;
                int c = 0;
#pragma unroll 1
                for (int i = 0; i < 8; ++i) c += (kl[tid + 256 * i] == K && (tid + 256 * i) <= mid) ? 1 : 0;
                const int tot = half_sum_i(c, red, hf, w4);
                if (lo < hi) { if (tot >= r) hi = mid; else lo = mid + 1; }
            }
            int cut = lo;
            if (t + 1 <= 256) { K = 0u; cut = SEQ; }
            float mx0 = -INFINITY, mx1 = -INFINITY, mx2 = -INFINITY, mx3 = -INFINITY;
#pragma unroll 1
            for (int i = 0; i < 8; ++i) {
                const int s = tid + 256 * i;
                const unsigned key = kl[s];
                const bool sel = (s <= t) && (key > K || (key == K && s <= cut));
                float l0 = -INFINITY, l1 = -INFINITY, l2 = -INFINITY, l3 = -INFINITY;
                if (sel) {
                    const bf16_t* kr = P + (size_t)(b * SEQ + s) * DINP + C_DK;
                    float a0 = 0.f, a1 = 0.f, a2 = 0.f, a3 = 0.f;
#pragma unroll 2
                    for (int d = 0; d < 64; d += 8) {
                        float kv[8]; ld8(kr + d, kv);
#pragma unroll
                        for (int q = 0; q < 8; ++q) { a0 += qd[d + q] * kv[q]; a1 += qd[64 + d + q] * kv[q]; a2 += qd[128 + d + q] * kv[q]; a3 += qd[192 + d + q] * kv[q]; }
                    }
                    const int bk = rel_bucket(t - s);
                    l0 = a0 + rel_bias[bk * 12 + 0]; l1 = a1 + rel_bias[bk * 12 + 1]; l2 = a2 + rel_bias[bk * 12 + 2]; l3 = a3 + rel_bias[bk * 12 + 3];
                    mx0 = fmaxf(mx0, l0); mx1 = fmaxf(mx1, l1); mx2 = fmaxf(mx2, l2); mx3 = fmaxf(mx3, l3);
                }
                lg[s] = l0; lg[2048 + s] = l1; lg[4096 + s] = l2; lg[6144 + s] = l3;
            }
            mx0 = wave_max(mx0); mx1 = wave_max(mx1); mx2 = wave_max(mx2); mx3 = wave_max(mx3);
            if ((tid & 63) == 0) { redf[w4 * 8 + 0] = mx0; redf[w4 * 8 + 1] = mx1; redf[w4 * 8 + 2] = mx2; redf[w4 * 8 + 3] = mx3; }
            __syncthreads();
            {
                const int h = tid >> 6;
                const float m = fmaxf(fmaxf(redf[h], redf[8 + h]), fmaxf(redf[16 + h], redf[24 + h]));
                float sm = 0.f;
#pragma unroll 1
                for (int s = (tid & 63); s < 2048; s += 64) { const float l = lg[h * 2048 + s]; const float e = (l == -INFINITY) ? 0.f : expf(l - m); lg[h * 2048 + s] = e; sm += e; }
                sm = wave_sum(sm);
                const int d = tid & 63;
                float acc = 0.f;
                const bf16_t* vb = P + (size_t)(b * SEQ) * DINP + C_DV + d;
#pragma unroll 1
                for (int s = 0; s <= t; ++s) {
                    const float pv = lg[h * 2048 + s];
                    if (pv != 0.f) acc += pv * bf2f(vb[(size_t)s * DINP]);
                }
                OM[(size_t)tg * DM + 256 + h * 64 + d] = (bf16_t)(pk2(acc / sm, 0.f) & 0xffffu);
            }
        }
    }
}

__device__ __forceinline__ void swa_simple(const Frame& F0, int L) {
    const Frame F = reframe(F0);
    const bf16_t* P = (const bf16_t*)(F.ws + WS_P);
    bf16_t* OM = (bf16_t*)(F.ws + WS_OMIX);
    const float* rel_bias = F.p->in[2]; const float* sinks = F.p->in[8] + L * 8;
    const int hf = F.tid >> 8, tid = F.tid & 255;
    LAS float* q = (LAS float*)(F.lds + hf * 8192);
    LAS float* lg = q + 512;
    for (int tile = F.bid; tile < 256; tile += F.G) {
        for (int it = 0; it < 32; ++it) {
            const int tg = tile * 64 + it * 2 + hf, b = tg / SEQ, t = tg % SEQ;
            __syncthreads();
            const bf16_t* pr = P + (size_t)tg * DINP;
            q[tid] = bf2f(pr[C_SQ + tid]) * 0.125f; q[tid + 256] = bf2f(pr[C_SQ + 256 + tid]) * 0.125f;
            __syncthreads();
#pragma unroll
            for (int i = 0; i < 4; ++i) {
                const int idx = tid + 256 * i, h = idx >> 7, j = idx & 127, s = t - 127 + j;
                float l = -INFINITY;
                if (s >= 0) {
                    const bf16_t* kr = P + (size_t)(b * SEQ + s) * DINP + C_SK + (h >> 2) * 64;
                    float acc = 0.f;
                    for (int d = 0; d < 64; d += 8) { float kv[8]; ld8(kr + d, kv);
#pragma unroll
                        for (int qq = 0; qq < 8; ++qq) acc += q[h * 64 + d + qq] * kv[qq]; }
                    l = acc + rel_bias[rel_bucket(127 - j) * 12 + 4 + h];
                }
                lg[idx] = l;
            }
            __syncthreads();
            {
                const int w = tid >> 6, lane = tid & 63;
#pragma unroll
                for (int hh = 0; hh < 2; ++hh) {
                    const int h = w * 2 + hh;
                    const float l0 = lg[h * 128 + lane], l1 = lg[h * 128 + 64 + lane];
                    const float sk = sinks[h];
                    const float m = fmaxf(wave_max(fmaxf(l0, l1)), sk);
                    const float e0 = expf(l0 - m), e1 = expf(l1 - m);
                    const float den = wave_sum(e0 + e1) + expf(sk - m);
                    lg[h * 128 + lane] = e0 / den; lg[h * 128 + 64 + lane] = e1 / den;
                }
            }
            __syncthreads();
#pragma unroll
            for (int i = 0; i < 2; ++i) {
                const int idx = tid + 256 * i, h = idx >> 6, d = idx & 63;
                float acc = 0.f;
                for (int j = 0; j < 128; ++j) {
                    const int s = t - 127 + j;
                    if (s >= 0) acc += lg[h * 128 + j] * bf2f(P[(size_t)(b * SEQ + s) * DINP + C_SV + (h >> 2) * 64 + d]);
                }
                OM[(size_t)tg * DM + 512 + h * 64 + d] = (bf16_t)(pk2(acc, 0.f) & 0xffffu);
            }
        }
    }
}

__device__ __forceinline__ unsigned sortable_key(float v) { const unsigned u = __float_as_uint(v + 0.0f); return (u & 0x80000000u) ? ~u : (u | 0x80000000u); }
__device__ __forceinline__ bf16x8 pack8(const float (&p)[8]) {
    u32x4 w; w.x = pk2(p[0], p[1]); w.y = pk2(p[2], p[3]); w.z = pk2(p[4], p[5]); w.w = pk2(p[6], p[7]);
    return __builtin_bit_cast(bf16x8, w);
}
#define S_STRIDE 2052
template <int MODE>
__device__ __forceinline__ void attn_step(const bf16_t* Kp, const bf16_t* VTp, const int s0, const int lane, const bf16x8 (&qb)[4][2],
                                          f32x4 (&O)[4][4], float (&mrun)[4], float (&lrun)[4], const int (&tq)[4],
                                          const LAS float* S, const unsigned (&Kq)[4], const int (&cutq)[4], const int (&qloc)[4], const LAS float* biasRow) {
    const int r = lane & 15, g = lane >> 4;
    bf16x8 ka[2][2], va[4];
#pragma unroll
    for (int blk = 0; blk < 2; ++blk) { int krow = s0 + 8 * (r >> 2) + 4 * blk + (r & 3); krow = krow < 0 ? 0 : (krow > SEQ - 1 ? SEQ - 1 : krow);
#pragma unroll
        for (int kk = 0; kk < 2; ++kk) ka[blk][kk] = *(const bf16x8*)(Kp + (size_t)krow * DINP + kk * 32 + 8 * g); }
    { int sv = s0 + 8 * g; sv = sv < 0 ? 0 : (sv > SEQ - 8 ? SEQ - 8 : sv);
#pragma unroll
      for (int db = 0; db < 4; ++db) va[db] = *(const bf16x8*)(VTp + (size_t)(db * 16 + r) * SEQ + sv); }
#pragma unroll
    for (int cg = 0; cg < 4; ++cg) {
        f32x4 a0 = (f32x4){0.f, 0.f, 0.f, 0.f}, a1 = a0;
        a0 = __builtin_amdgcn_mfma_f32_16x16x32_bf16(ka[0][0], qb[cg][0], a0, 0, 0, 0); a0 = __builtin_amdgcn_mfma_f32_16x16x32_bf16(ka[0][1], qb[cg][1], a0, 0, 0, 0);
        a1 = __builtin_amdgcn_mfma_f32_16x16x32_bf16(ka[1][0], qb[cg][0], a1, 0, 0, 0); a1 = __builtin_amdgcn_mfma_f32_16x16x32_bf16(ka[1][1], qb[cg][1], a1, 0, 0, 0);
        float lg[8]; bool sel[8];
        f32x4 sv0, sv1;
        if (MODE == 0) { sv0 = *(const LAS f32x4*)(S + qloc[cg] * S_STRIDE + s0 + 8 * g); sv1 = *(const LAS f32x4*)(S + qloc[cg] * S_STRIDE + s0 + 8 * g + 4); }
        float mb = -INFINITY;
#pragma unroll
        for (int j = 0; j < 8; ++j) {
            const int sidx = s0 + 8 * g + j; const int dist = tq[cg] - sidx;
            const float raw = (j < 4) ? a0[j & 3] : a1[j & 3];
            if (MODE == 0) { const unsigned key = sortable_key(j < 4 ? sv0[j & 3] : sv1[j & 3]); sel[j] = (dist >= 0) && (key > Kq[cg] || (key == Kq[cg] && sidx <= cutq[cg])); }
            else sel[j] = (dist >= 0) && (dist < 128) && (sidx >= 0);
            const int dc = dist < 0 ? 0 : (dist > 127 ? 127 : dist);
            lg[j] = sel[j] ? raw * 0.125f + biasRow[dc] : -INFINITY;
            mb = fmaxf(mb, lg[j]);
        }
        mb = fmaxf(mb, __shfl_xor(mb, 16)); mb = fmaxf(mb, __shfl_xor(mb, 32));
        const float mn = fmaxf(mrun[cg], mb);
        const float alpha = (mn == -INFINITY) ? 1.0f : __expf(mrun[cg] - mn);
        float p[8], ps = 0.f;
#pragma unroll
        for (int j = 0; j < 8; ++j) { p[j] = sel[j] ? __expf(lg[j] - mn) : 0.f; ps += p[j]; }
        lrun[cg] = lrun[cg] * alpha + ps; mrun[cg] = mn;
        const bf16x8 pb = pack8(p);
#pragma unroll
        for (int db = 0; db < 4; ++db) { O[db][cg] = O[db][cg] * alpha; O[db][cg] = __builtin_amdgcn_mfma_f32_16x16x32_bf16(va[db], pb, O[db][cg], 0, 0, 0); }
    }
}

__device__ __forceinline__ int wave_sum_i(int v) {
#pragma unroll
    for (int o = 32; o > 0; o >>= 1) v += __shfl_xor(v, o);
    return v;
}
__device__ __forceinline__ void dsa_mfma(const Frame& F0) {
    const Frame F = reframe(F0);
    const bf16_t* P = (const bf16_t*)(F.ws + WS_P);
    const bf16_t* VT = (const bf16_t*)(F.ws + WS_VT);
    bf16_t* OM = (bf16_t*)(F.ws + WS_OMIX);
    const float* rel_bias = F.p->in[2];
    LAS float* S = (LAS float*)F.lds;
    LAS float* biasT = (LAS float*)(F.lds + 139264);
    LAS unsigned* selK = (LAS unsigned*)(F.lds + 139264 + 2048);
    LAS int* selCut = (LAS int*)(selK + 16);
    LAS float* cm = (LAS float*)(selCut + 16);
    LAS float* cl = cm + 512;
    const int w = F.wave;
    __syncthreads();
    for (int i = F.tid; i < 512; i += NTHREADS) { const int h = i >> 7, d = i & 127; biasT[i] = rel_bias[rel_bucket(d) * 12 + h]; }
    for (int wg = F.bid; wg < 256; wg += F.G) {
        const int b = wg >> 5, ii = wg & 31;
#pragma unroll 1
        for (int sub = 0; sub < 4; ++sub) {
            int lane = F.lane; asm volatile("" : "+v"(lane));
            const int r = lane & 15, g = lane >> 4;
            const int pos = (sub == 0) ? ii : (sub == 1) ? 63 - ii : (sub == 2) ? 64 + ii : 127 - ii;
            const int t0 = pos * 16, nk = t0 + 16;
            const bf16_t* Pb = P + (size_t)b * SEQ * DINP;
            __syncthreads();
            {
                bf16x8 bq[8][2]; float wv[8];
                const bf16_t* qrow = Pb + (size_t)(t0 + r) * DINP;
#pragma unroll
                for (int h = 0; h < 8; ++h) { bq[h][0] = *(const bf16x8*)(qrow + C_IQ + h * 64 + 8 * g); bq[h][1] = *(const bf16x8*)(qrow + C_IQ + h * 64 + 32 + 8 * g); wv[h] = bf2f(qrow[C_IW + h]) * 0.04419417382415922f; }
#pragma unroll 1
                for (int kb = w; kb < (nk >> 4); kb += 8) {
                    const int s0 = kb * 16;
                    const bf16_t* krow = Pb + (size_t)(s0 + r) * DINP + C_IK + 8 * g;
                    const bf16x8 k0 = *(const bf16x8*)krow, k1 = *(const bf16x8*)(krow + 32);
                    f32x4 sc = (f32x4){0.f, 0.f, 0.f, 0.f};
#pragma unroll
                    for (int h = 0; h < 8; ++h) {
                        f32x4 a = (f32x4){0.f, 0.f, 0.f, 0.f};
                        a = __builtin_amdgcn_mfma_f32_16x16x32_bf16(k0, bq[h][0], a, 0, 0, 0); a = __builtin_amdgcn_mfma_f32_16x16x32_bf16(k1, bq[h][1], a, 0, 0, 0);
#pragma unroll
                        for (int i = 0; i < 4; ++i) sc[i] += wv[h] * fmaxf(a[i], 0.f);
                    }
                    *(LAS f32x4*)(S + r * S_STRIDE + s0 + 4 * g) = sc;
                }
            }
            __syncthreads();
#pragma unroll 1
            for (int qq = 0; qq < 2; ++qq) {
                const int q = 2 * w + qq, tqv = t0 + q;
                unsigned K = 0u; int cut = SEQ;
                if (tqv + 1 > 256) {
                    unsigned keys[32];
#pragma unroll
                    for (int c = 0; c < 8; ++c) { const int sb = 4 * lane + 256 * c;
                        f32x4 v = (f32x4){0.f, 0.f, 0.f, 0.f};
                        if (sb < nk) v = *(const LAS f32x4*)(S + q * S_STRIDE + sb);
#pragma unroll
                        for (int m = 0; m < 4; ++m) keys[4 * c + m] = (sb + m <= tqv) ? sortable_key(v[m]) : 0u; }
#pragma unroll 1
                    for (int bit = 31; bit >= 0; --bit) {
                        const unsigned cand = K | (1u << bit);
                        int c = 0;
#pragma unroll
                        for (int i = 0; i < 32; ++i) c += (keys[i] >= cand) ? 1 : 0;
                        if (wave_sum_i(c) >= 256) K = cand;
                    }
                    int cg_ = 0, ce_ = 0;
#pragma unroll
                    for (int i = 0; i < 32; ++i) { cg_ += (keys[i] > K) ? 1 : 0; ce_ += (keys[i] == K) ? 1 : 0; }
                    const int ngt = wave_sum_i(cg_), neq = wave_sum_i(ce_), rr = 256 - ngt;
                    if (neq > rr) {
                        int lo = 0, hi = SEQ - 1;
#pragma unroll 1
                        while (lo < hi) {
                            const int mid = (lo + hi) >> 1;
                            int c = 0;
#pragma unroll
                            for (int i = 0; i < 32; ++i) c += (keys[i] == K && (4 * lane + 256 * (i >> 2) + (i & 3)) <= mid) ? 1 : 0;
                            if (wave_sum_i(c) >= rr) hi = mid; else lo = mid + 1;
                        }
                        cut = lo;
                    }
                }
                if (lane == 0) { selK[q] = K; selCut[q] = cut; }
            }
            __syncthreads();
            f32x4 O[4][4]; float mrun[4], lrun[4];
            {
                bf16x8 qb[4][2]; int tq[4], qloc[4], cutq[4]; unsigned Kq[4];
#pragma unroll
                for (int cg = 0; cg < 4; ++cg) {
                    qloc[cg] = 4 * cg + (r >> 2); tq[cg] = t0 + qloc[cg]; Kq[cg] = selK[qloc[cg]]; cutq[cg] = selCut[qloc[cg]];
                    const bf16_t* qrow = Pb + (size_t)tq[cg] * DINP + C_DQ + (r & 3) * 64 + 8 * g;
                    qb[cg][0] = *(const bf16x8*)qrow; qb[cg][1] = *(const bf16x8*)(qrow + 32);
                    mrun[cg] = -INFINITY; lrun[cg] = 0.f;
#pragma unroll
                    for (int db = 0; db < 4; ++db) O[db][cg] = (f32x4){0.f, 0.f, 0.f, 0.f};
                }
                const LAS float* biasRow = biasT + (r & 3) * 128;
                const bf16_t* Kp = Pb + C_DK; const bf16_t* VTp = VT + (size_t)b * 64 * SEQ;
#pragma unroll 1
                for (int sb = w; sb < ((nk + 31) >> 5); sb += 8) attn_step<0>(Kp, VTp, sb * 32, lane, qb, O, mrun, lrun, tq, S, Kq, cutq, qloc, biasRow);
            }
#pragma unroll
            for (int cg = 0; cg < 4; ++cg) { lrun[cg] += __shfl_xor(lrun[cg], 16); lrun[cg] += __shfl_xor(lrun[cg], 32); }
            if (g == 0) {
#pragma unroll
                for (int cg = 0; cg < 4; ++cg) { cm[w * 64 + cg * 16 + r] = mrun[cg]; cl[w * 64 + cg * 16 + r] = lrun[cg]; }
            }
            __syncthreads();
#pragma unroll
            for (int cg = 0; cg < 4; ++cg) {
                const int col = cg * 16 + r;
                float mt = -INFINITY;
#pragma unroll
                for (int ww = 0; ww < 8; ++ww) mt = fmaxf(mt, cm[ww * 64 + col]);
                float lt = 0.f;
#pragma unroll
                for (int ww = 0; ww < 8; ++ww) { const float mw = cm[ww * 64 + col]; lt += (mw == -INFINITY) ? 0.f : cl[ww * 64 + col] * __expf(mw - mt); }
                const float f = (mrun[cg] == -INFINITY) ? 0.f : __expf(mrun[cg] - mt) / lt;
#pragma unroll
                for (int db = 0; db < 4; ++db) *(LAS f32x4*)(S + (w * 64 + col) * 68 + db * 16 + 4 * g) = O[db][cg] * f;
            }
            __syncthreads();
#pragma unroll
            for (int it = 0; it < 2; ++it) {
                const int item = (w * 64 + lane) + NTHREADS * it, col = item >> 4, d4 = (item & 15) * 4;
                f32x4 acc = (f32x4){0.f, 0.f, 0.f, 0.f};
#pragma unroll
                for (int ww = 0; ww < 8; ++ww) acc += *(const LAS f32x4*)(S + (ww * 64 + col) * 68 + d4);
                u32x2 o; o.x = pk2(acc[0], acc[1]); o.y = pk2(acc[2], acc[3]);
                *(u32x2*)(OM + (size_t)(b * SEQ + t0 + (col >> 2)) * DM + 256 + (col & 3) * 64 + d4) = o;
            }
        }
    }
}

__device__ __forceinline__ void swa_mfma(const Frame& F0, int L) {
    const Frame F = reframe(F0);
    const bf16_t* P = (const bf16_t*)(F.ws + WS_P);
    const bf16_t* SVT = (const bf16_t*)(F.ws + WS_SVT);
    bf16_t* OM = (bf16_t*)(F.ws + WS_OMIX);
    const float* rel_bias = F.p->in[2]; const float* sinks = F.p->in[8] + L * 8;
    LAS float* biasT = (LAS float*)F.lds;
    const int lane = F.lane, r = lane & 15, g = lane >> 4, w = F.wave;
    __syncthreads();
    for (int i = F.tid; i < 1024; i += NTHREADS) { const int h = i >> 7, d = i & 127; biasT[i] = rel_bias[rel_bucket(d) * 12 + 4 + h]; }
    __syncthreads();
    const int kvh = w >> 2, q0 = (w & 3) * 16, hq = kvh * 4 + (r & 3);
    const float sink = sinks[hq];
    for (int tile = F.bid; tile < 256; tile += F.G) {
        const int b = tile >> 5, t0 = (tile & 31) * 64;
        const bf16_t* Pb = P + (size_t)b * SEQ * DINP;
        f32x4 O[4][4]; float mrun[4], lrun[4]; bf16x8 qb[4][2]; int tq[4], qloc[4], cutq[4]; unsigned Kq[4];
#pragma unroll
        for (int cg = 0; cg < 4; ++cg) {
            qloc[cg] = 0; cutq[cg] = 0; Kq[cg] = 0u;
            tq[cg] = t0 + q0 + 4 * cg + (r >> 2);
            const bf16_t* qrow = Pb + (size_t)tq[cg] * DINP + C_SQ + hq * 64 + 8 * g;
            qb[cg][0] = *(const bf16x8*)qrow; qb[cg][1] = *(const bf16x8*)(qrow + 32);
            mrun[cg] = sink; lrun[cg] = (g == 0) ? 1.0f : 0.0f;
#pragma unroll
            for (int db = 0; db < 4; ++db) O[db][cg] = (f32x4){0.f, 0.f, 0.f, 0.f};
        }
        const bf16_t* Kp = Pb + C_SK + kvh * 64; const bf16_t* VTp = SVT + ((size_t)b * 128 + kvh * 64) * SEQ;
        const int sbase = t0 + q0 - 128;
#pragma unroll 1
        for (int sb = 0; sb < 5; ++sb) attn_step<1>(Kp, VTp, sbase + sb * 32, lane, qb, O, mrun, lrun, tq, nullptr, Kq, cutq, qloc, biasT + hq * 128);
#pragma unroll
        for (int cg = 0; cg < 4; ++cg) {
            lrun[cg] += __shfl_xor(lrun[cg], 16); lrun[cg] += __shfl_xor(lrun[cg], 32);
            const float inv = 1.0f / lrun[cg];
#pragma unroll
            for (int db = 0; db < 4; ++db) { const f32x4 o = O[db][cg] * inv; u32x2 ow; ow.x = pk2(o[0], o[1]); ow.y = pk2(o[2], o[3]);
                *(u32x2*)(OM + (size_t)(b * SEQ + tq[cg]) * DM + 512 + hq * 64 + db * 16 + 4 * g) = ow; }
        }
    }
}

__device__ __forceinline__ void phase_route(const Frame& F0, int L) {
    const Frame F = reframe(F0);
    const float* H = (const float*)(F.ws + WS_H);
    bf16_t* XN = (bf16_t*)(F.ws + WS_ABF);
    const float* g = F.p->in[10] + L * DM;
    const float* wrg = F.p->in[11] + (size_t)L * DM * 4; const float* brg = F.p->in[12] + L * 4;
    const float* wre = F.p->in[13] + (size_t)L * DM * 32; const float* bre = F.p->in[14] + L * 32;
    unsigned* cursor = (unsigned*)(F.ws + WS_CTL) + CW_CURSOR + L * 32;
    int* list = (int*)(F.ws + WS_LIST); unsigned* slot = (unsigned*)(F.ws + WS_SLOT); float* gate = (float*)(F.ws + WS_GATE);
    LAS float* wl = (LAS float*)F.lds;
    LAS float* lgs = (LAS float*)(F.lds + MISC_OFF + 64);
    LAS int* sl_e = (LAS int*)(F.lds + MISC_OFF + 64 + 8 * 72 * 4);
    LAS int* sl_rank = sl_e + 128;
    LAS int* lcnt = sl_rank + 128;
    LAS int* gbase = lcnt + 32;
    __syncthreads();
    for (int i = F.tid; i < DM * 4; i += NTHREADS) { const int k = i >> 2, j = i & 3; wl[j * 1024 + k] = wrg[i]; }
    for (int i = F.tid; i < DM * 32; i += NTHREADS) { const int k = i >> 5, j = i & 31; wl[(4 + j) * 1024 + k] = wre[i]; }
    f32x4 gv[4];
#pragma unroll
    for (int j = 0; j < 4; ++j) gv[j] = *(const f32x4*)(g + 4 * F.lane + 256 * j);
    for (int tile = F.bid; tile < 256; tile += F.G) {
        if (F.tid < 32) lcnt[F.tid] = 0;
        __syncthreads();
        for (int pr = 0; pr < 4; ++pr) {
            const int t0 = tile * 64 + F.wave * 8 + pr * 2;
            f32x4 xa[4], xb[4]; float sa = 0.f, sb = 0.f;
#pragma unroll
            for (int j = 0; j < 4; ++j) { xa[j] = *((const f32x4*)(H + (size_t)t0 * DM) + F.lane + 64 * j); xb[j] = *((const f32x4*)(H + (size_t)(t0 + 1) * DM) + F.lane + 64 * j);
                sa += xa[j][0] * xa[j][0] + xa[j][1] * xa[j][1] + xa[j][2] * xa[j][2] + xa[j][3] * xa[j][3]; sb += xb[j][0] * xb[j][0] + xb[j][1] * xb[j][1] + xb[j][2] * xb[j][2] + xb[j][3] * xb[j][3]; }
            const float ra = rsqrtf(wave_sum(sa) * (1.0f / DM) + EPS), rb = rsqrtf(wave_sum(sb) * (1.0f / DM) + EPS);
#pragma unroll
            for (int j = 0; j < 4; ++j) {
#pragma unroll
                for (int q = 0; q < 4; ++q) { xa[j][q] = xa[j][q] * ra * gv[j][q]; xb[j][q] = xb[j][q] * rb * gv[j][q]; }
                u32x2 oa, ob; oa.x = pk2(xa[j][0], xa[j][1]); oa.y = pk2(xa[j][2], xa[j][3]); ob.x = pk2(xb[j][0], xb[j][1]); ob.y = pk2(xb[j][2], xb[j][3]);
                *((u32x2*)(XN + (size_t)t0 * DM) + F.lane + 64 * j) = oa; *((u32x2*)(XN + (size_t)(t0 + 1) * DM) + F.lane + 64 * j) = ob;
            }
#pragma unroll 4
            for (int jj = 0; jj < 36; ++jj) {
                float da = 0.f, db = 0.f;
#pragma unroll
                for (int j = 0; j < 4; ++j) { const f32x4 w = *(const LAS f32x4*)(wl + jj * 1024 + 4 * F.lane + 256 * j);
                    da += xa[j][0] * w[0] + xa[j][1] * w[1] + xa[j][2] * w[2] + xa[j][3] * w[3]; db += xb[j][0] * w[0] + xb[j][1] * w[1] + xb[j][2] * w[2] + xb[j][3] * w[3]; }
                da = wave_sum(da); db = wave_sum(db);
                if (F.lane == 0) { lgs[F.wave * 72 + jj] = da; lgs[F.wave * 72 + 36 + jj] = db; }
            }
            asm volatile("s_waitcnt lgkmcnt(0)" ::: "memory");
            if (F.lane < 2) {
                const LAS float* lgp = lgs + F.wave * 72 + F.lane * 36; const int t = t0 + F.lane;
                float gl[4], m = -INFINITY;
                for (int j = 0; j < 4; ++j) { gl[j] = lgp[j] + brg[j]; m = fmaxf(m, gl[j]); }
                float sum = 0.f; for (int j = 0; j < 4; ++j) { gl[j] = expf(gl[j] - m); sum += gl[j]; }
                int gs = 0; float gw = gl[0] / sum;
                for (int j = 1; j < 4; ++j) { const float pj = gl[j] / sum; if (pj > gw) { gw = pj; gs = j; } }
                float el[8]; m = -INFINITY;
                for (int j = 0; j < 8; ++j) { el[j] = lgp[4 + gs * 8 + j] + bre[gs * 8 + j]; m = fmaxf(m, el[j]); }
                sum = 0.f; for (int j = 0; j < 8; ++j) { el[j] = expf(el[j] - m); sum += el[j]; }
                for (int j = 0; j < 8; ++j) el[j] = el[j] / sum;
                int i1 = 0; float e1v = el[0];
                for (int j = 1; j < 8; ++j) if (el[j] > e1v) { e1v = el[j]; i1 = j; }
                int i2 = -1; float e2v = -1.f;
                for (int j = 0; j < 8; ++j) if (j != i1 && el[j] > e2v) { e2v = el[j]; i2 = j; }
                const float es = e1v + e2v;
                const int ls = (t - tile * 64) * 2;
                sl_e[ls] = (gs * 8 + i1) & 31; sl_e[ls + 1] = (gs * 8 + i2) & 31;
                gate[2 * t] = gw * e1v / es; gate[2 * t + 1] = gw * e2v / es;
            }
        }
        __syncthreads();
        if (F.tid < 128) sl_rank[F.tid] = atomicAdd((int*)&lcnt[sl_e[F.tid]], 1);
        __syncthreads();
        if (F.tid < 32) gbase[F.tid] = (int)__hip_atomic_fetch_add(&cursor[F.tid], (unsigned)lcnt[F.tid], __ATOMIC_RELAXED, __HIP_MEMORY_SCOPE_AGENT);
        __syncthreads();
        if (F.tid < 128) { const int e = sl_e[F.tid], pos = gbase[e] + sl_rank[F.tid], t = tile * 64 + (F.tid >> 1);
            list[(size_t)e * LIST_CAP + pos] = t; slot[2 * t + (F.tid & 1)] = ((unsigned)e << 16) | (unsigned)pos; }
        __syncthreads();
    }
}
__device__ __forceinline__ void moe_tables(const Frame& F0, int L, LAS int* cntv, LAS int* mtp) {
    const Frame F = reframe(F0);
    unsigned* cursor = (unsigned*)(F.ws + WS_CTL) + CW_CURSOR + L * 32;
    __syncthreads();
    if (F.tid < 32) cntv[F.tid] = (int)__hip_atomic_load(&cursor[F.tid], __ATOMIC_RELAXED, __HIP_MEMORY_SCOPE_AGENT);
    __syncthreads();
    if (F.tid == 0) { int run = 0; for (int e = 0; e < NEXP; ++e) { mtp[e] = run; run += (cntv[e] + 255) >> 8; } mtp[NEXP] = run; }
    __syncthreads();
}
__device__ __forceinline__ void phase_combine(const Frame& F0, int L) {
    const Frame F = reframe(F0);
    float* H = (float*)(F.ws + WS_H); bf16_t* HB = (bf16_t*)(F.ws + WS_ABF);
    const bf16_t* Y = (const bf16_t*)(F.ws + WS_P); const bf16_t* EP = (const bf16_t*)(F.ws + WS_EPRE);
    const unsigned* slot = (const unsigned*)(F.ws + WS_SLOT); const float* gate = (const float*)(F.ws + WS_GATE); float* erstd = (float*)(F.ws + WS_ERSTD);
    LAS int* cntv = (LAS int*)(F.lds + MISC_OFF + 64); LAS int* mtp = cntv + 32;
    moe_tables(F, L, cntv, mtp);
    const int gw = F.bid * 8 + F.wave, NGW = F.G * 8;
    for (int t = gw; t < T_TOK; t += NGW) {
        const unsigned s0 = slot[2 * t], s1 = slot[2 * t + 1];
        size_t r0 = (size_t)mtp[(s0 >> 16) & 31] * 256 + (s0 & 0x7fffu), r1 = (size_t)mtp[(s1 >> 16) & 31] * 256 + (s1 & 0x7fffu);
        r0 = r0 < MOE_PROWS ? r0 : 0; r1 = r1 < MOE_PROWS ? r1 : 0;
        const float g0 = gate[2 * t], g1 = gate[2 * t + 1];
        float ss = 0.f;
#pragma unroll
        for (int j = 0; j < 4; ++j) {
            const u32x2 ya = *((const u32x2*)(Y + r0 * DM) + F.lane + 64 * j), yb = *((const u32x2*)(Y + r1 * DM) + F.lane + 64 * j);
            f32x4 h = *((f32x4*)(H + (size_t)t * DM) + F.lane + 64 * j);
            h[0] += blo(ya.x) * g0 + blo(yb.x) * g1; h[1] += bhi(ya.x) * g0 + bhi(yb.x) * g1; h[2] += blo(ya.y) * g0 + blo(yb.y) * g1; h[3] += bhi(ya.y) * g0 + bhi(yb.y) * g1;
            *((f32x4*)(H + (size_t)t * DM) + F.lane + 64 * j) = h;
            u32x2 o; o.x = pk2(h[0], h[1]); o.y = pk2(h[2], h[3]);
            *((u32x2*)(HB + (size_t)t * DM) + F.lane + 64 * j) = o;
            const u32x2 ew = *((const u32x2*)(EP + (size_t)t * DM) + F.lane + 64 * j);
            ss += blo(ew.x) * blo(ew.x) + bhi(ew.x) * bhi(ew.x) + blo(ew.y) * blo(ew.y) + bhi(ew.y) * bhi(ew.y);
        }
        ss = wave_sum(ss);
        if (F.lane == 0) erstd[t] = rsqrtf(ss * (1.0f / DM) + EPS);
    }
}

#define N_PHASES (1 + 2 * 10 + 1)
#define IN(k) (lo <= (k) && (k) < hi)
#define SEAM(k) do { if (!MK_PER_PHASE && IN((k) + 1)) xcd_barrier(bar); } while (0)
template <int L>
__device__ __forceinline__ void run_layer(const Frame& F, const Params& prm, const XcdBarrier& bar, const int lo, const int hi) {
    float* H = (float*)(F.ws + WS_H);
    bf16_t* ABF = (bf16_t*)(F.ws + WS_ABF);
    const int vcu = (F.G % 8 == 0) ? (F.bid % 8) * (F.G / 8) + F.bid / 8 : F.bid;
    LAS int* cntv = (LAS int*)(F.lds + MISC_OFF + 64); LAS int* mtp = cntv + 32;
    constexpr int pb = 1 + L * 10;
    if (IN(pb + 0)) { phase_norm_bf16(F, L == 0 ? prm.in[0] : H, prm.in[3] + L * DM, ABF); SEAM(pb + 0); }
    if (IN(pb + 1)) {
        pg8::DenseSched S; S.init(ABF, F.ws + WS_WIN + L * SZ_WIN, T_TOK, DINP, DM, F.G, F.bid);
        pg8::EpiInProj E{(bf16_t*)(F.ws + WS_P), (bf16_t*)(F.ws + WS_VT), (bf16_t*)(F.ws + WS_SVT)};
        pg8::gemm_phase(F.lds, DM, DM, S, E);
        SEAM(pb + 1);
    }
    if (IN(pb + 2)) { dsa_mfma(F); gla_local(F, L); SEAM(pb + 2); }
    if (IN(pb + 3)) { gla_final(F, L); swa_mfma(F, L); SEAM(pb + 3); }
    if (IN(pb + 4)) {
        pg8::DenseSched S; S.init(F.ws + WS_OMIX, F.ws + WS_WOUT + L * SZ_WOUT, T_TOK, DM, DM, F.G, F.bid);
        pg8::EpiResid E{L == 0 ? prm.in[0] : H, H};
        pg8::gemm_phase(F.lds, DM, DM, S, E);
        SEAM(pb + 4);
    }
    if (IN(pb + 5)) { phase_route(F, L); SEAM(pb + 5); }
    if (IN(pb + 6)) {
        moe_tables(F, L, cntv, mtp);
        pg8::MoeSched S; S.A = (const char*)ABF; S.Bt = (const char*)(F.ws + WS_WGU + L * SZ_WGU); S.list = (const int*)(F.ws + WS_LIST); S.mtp = mtp; S.cntv = cntv;
        S.K = DM; S.Kb = DM; S.G = F.G; S.c = vcu; S.gather = true; S.bstride = (size_t)1024 * DM * 2;
        pg8::EpiGateUp E{(bf16_t*)(F.ws + WS_HMID)};
        pg8::gemm_phase(F.lds, DM, DM, S, E);
        SEAM(pb + 6);
    }
    if (IN(pb + 7)) {
        moe_tables(F, L, cntv, mtp);
        { pg8::MoeSched S; S.A = (const char*)(F.ws + WS_HMID); S.Bt = (const char*)(F.ws + WS_WD + L * SZ_WD); S.list = nullptr; S.mtp = mtp; S.cntv = cntv;
          S.K = DEXP; S.Kb = DEXP; S.G = F.G; S.c = vcu; S.gather = false; S.bstride = (size_t)DM * DEXP * 2;
          pg8::EpiBf16 E{(bf16_t*)(F.ws + WS_P), DM};
          pg8::gemm_phase(F.lds, DEXP, DEXP, S, E); }
        { pg8::DenseSched S; S.init(F.ws + WS_PBF + L * SZ_PBF, F.ws + WS_WPLE + L * SZ_WPLE, T_TOK, DM, PLE_D, F.G, F.bid);
          pg8::EpiBf16 E{(bf16_t*)(F.ws + WS_EPRE), DM};
          pg8::gemm_phase(F.lds, PLE_D, PLE_D, S, E); }
        SEAM(pb + 7);
    }
    if (IN(pb + 8)) { phase_combine(F, L); SEAM(pb + 8); }
    if (IN(pb + 9)) {
        pg8::DenseSched S; S.init(ABF, F.ws + WS_WPG + L * SZ_WPG, T_TOK, DM, DM, F.G, F.bid);
        pg8::EpiPleGate E{H, (const bf16_t*)(F.ws + WS_EPRE), (const float*)(F.ws + WS_ERSTD), prm.in[19] + L * DM};
        pg8::gemm_phase(F.lds, DM, DM, S, E);
        SEAM(pb + 9);
    }
}
__global__ void __launch_bounds__(NTHREADS, 2) mk_fwd(Params prm) {
    extern __shared__ __attribute__((aligned(16))) unsigned char lds_raw[];
    Frame F; F.lds = (LAS unsigned char*)lds_raw; F.tid = threadIdx.x; F.lane = F.tid & 63; F.wave = __builtin_amdgcn_readfirstlane(F.tid >> 6);
    F.G = gridDim.x; F.bid = blockIdx.x; F.p = &prm; F.ws = prm.ws;
    volatile LAS unsigned* misc = (volatile LAS unsigned*)(F.lds + MISC_OFF);
    if (F.tid < 4) misc[F.tid] = 0u;
    __syncthreads();
    XcdBarrier bar; bar.bar = (unsigned*)(F.ws + WS_CTL) + CW_BAR; bar.x = 0; bar.st = misc;
    if (!MK_PER_PHASE) bar = xcd_barrier_post((unsigned*)(F.ws + WS_CTL) + CW_BAR, misc);
    const int lo = prm.ph_lo, hi = prm.ph_hi;
    if (IN(0)) { phase_prologue(F); SEAM(0); }
    run_layer<0>(F, prm, bar, lo, hi);
    run_layer<1>(F, prm, bar, lo, hi);
    if (IN(21)) phase_final(F, (const float*)(F.ws + WS_H), prm.in[21], prm.out);
}
#undef IN
#undef SEAM

extern "C" void kernel_launch(void* const* d_in, const int* in_sizes, int n_in, void* d_out, int out_size, void* d_ws, size_t ws_size, hipStream_t stream) {
    static int grid = 0;
    if (!grid) {
        if (n_in != 22 || ws_size < WS_END) { grid = -1; return; }
        int dev = 0, cus = 0, per_cu = 0;
        if (hipGetDevice(&dev) != hipSuccess || hipDeviceGetAttribute(&cus, hipDeviceAttributeMultiprocessorCount, dev) != hipSuccess) { grid = -1; return; }
        if (hipFuncSetAttribute((const void*)mk_fwd, hipFuncAttributeMaxDynamicSharedMemorySize, LDS_BYTES) != hipSuccess) { grid = -1; return; }
        if (hipOccupancyMaxActiveBlocksPerMultiprocessor(&per_cu, (const void*)mk_fwd, NTHREADS, LDS_BYTES) != hipSuccess || per_cu < 1) { grid = -1; return; }
        grid = cus;
        if (grid > 256) grid = 256;
    }
    if (grid < 0) return;
    (void)hipMemsetAsync((char*)d_ws + WS_CTL, 0, CTL_BYTES, stream);
    Params p{};
    for (int i = 0; i < 22; ++i) p.in[i] = (const float*)d_in[i];
    p.out = (float*)d_out; p.ws = (unsigned char*)d_ws;
#if MK_PER_PHASE
    for (int ph = 0; ph < N_PHASES; ++ph) { p.ph_lo = ph; p.ph_hi = ph + 1; hipLaunchKernelGGL(mk_fwd, dim3(grid), dim3(NTHREADS), LDS_BYTES, stream, p); }
#else
    p.ph_lo = 0; p.ph_hi = N_PHASES;
    hipLaunchKernelGGL(mk_fwd, dim3(grid), dim3(NTHREADS), LDS_BYTES, stream, p);
#endif
}
```

```cpp
#include <hip/hip_runtime.h>
#include <stdint.h>

#ifndef MK_PER_PHASE
#define MK_PER_PHASE 0
#endif

#define LAS __attribute__((address_space(3)))
typedef unsigned short bf16_t;
typedef short bf16x8 __attribute__((ext_vector_type(8)));
typedef float f32x4 __attribute__((ext_vector_type(4)));
typedef float f32x2 __attribute__((ext_vector_type(2)));
typedef unsigned u32x4 __attribute__((ext_vector_type(4)));
typedef unsigned u32x2 __attribute__((ext_vector_type(2)));

#define T_TOK 16384
#define SEQ 2048
#define DM 1024
#define DIN 2520
#define DINP 2560
#define PLE_D 256
#define NEXP 32
#define DEXP 512
#define LIST_CAP 32768
#define MOE_PROWS 40960
#define C_GQ 0
#define C_GK 128
#define C_GV 256
#define C_GG 512
#define C_GA 768
#define C_DQ 784
#define C_DK 1040
#define C_DV 1104
#define C_IQ 1168
#define C_IK 1680
#define C_IW 1744
#define C_SQ 1752
#define C_SK 2264
#define C_SV 2392
#define EPS 1e-6f
#define NTHREADS 512
#define LDS_BYTES 159744
#define MISC_OFF 147456

constexpr size_t WS_CTL = 0;
constexpr size_t CTL_BYTES = 32768;
constexpr size_t WS_WIN = WS_CTL + CTL_BYTES;
constexpr size_t SZ_WIN = (size_t)DINP * DM * 2;
constexpr size_t WS_WOUT = WS_WIN + 2 * SZ_WIN;
constexpr size_t SZ_WOUT = (size_t)DM * DM * 2;
constexpr size_t WS_WGU = WS_WOUT + 2 * SZ_WOUT;
constexpr size_t SZ_WGU = (size_t)NEXP * 1024 * DM * 2;
constexpr size_t WS_WD = WS_WGU + 2 * SZ_WGU;
constexpr size_t SZ_WD = (size_t)NEXP * DM * DEXP * 2;
constexpr size_t WS_WPLE = WS_WD + 2 * SZ_WD;
constexpr size_t SZ_WPLE = (size_t)DM * PLE_D * 2;
constexpr size_t WS_WPG = WS_WPLE + 2 * SZ_WPLE;
constexpr size_t SZ_WPG = (size_t)DM * DM * 2;
constexpr size_t WS_PBF = WS_WPG + 2 * SZ_WPG;
constexpr size_t SZ_PBF = (size_t)T_TOK * PLE_D * 2;
constexpr size_t WS_H = WS_PBF + 2 * SZ_PBF;
constexpr size_t WS_ABF = WS_H + (size_t)T_TOK * DM * 4;
constexpr size_t WS_P = WS_ABF + (size_t)T_TOK * DM * 2;
constexpr size_t WS_OMIX = WS_P + (size_t)T_TOK * DINP * 2;
constexpr size_t WS_HMID = WS_OMIX + (size_t)T_TOK * DM * 2;
constexpr size_t WS_EPRE = WS_OMIX;
constexpr size_t WS_GU = WS_HMID + (size_t)MOE_PROWS * DEXP * 2;
constexpr size_t WS_GD = WS_GU + (size_t)256 * 4 * 2048 * 4;
constexpr size_t WS_LIST = WS_GD + (size_t)256 * 128 * 4;
constexpr size_t WS_SLOT = WS_LIST + (size_t)NEXP * LIST_CAP * 4;
constexpr size_t WS_GATE = WS_SLOT + (size_t)T_TOK * 2 * 4;
constexpr size_t WS_ERSTD = WS_GATE + (size_t)T_TOK * 2 * 4;
constexpr size_t WS_VT = WS_ERSTD + (size_t)T_TOK * 4;
constexpr size_t WS_SVT = WS_VT + (size_t)8 * 64 * SEQ * 2;
constexpr size_t WS_WR = WS_SVT + (size_t)8 * 128 * SEQ * 2;
constexpr size_t WS_END = WS_WR + (size_t)2 * 2 * 48 * DM * 2;
#define CW_BAR 0
#define CW_CURSOR 4096

__device__ __forceinline__ float bf2f(unsigned b) { return __uint_as_float(b << 16); }
__device__ __forceinline__ unsigned pk2(float lo, float hi) { unsigned r; asm("v_cvt_pk_bf16_f32 %0, %1, %2" : "=v"(r) : "v"(lo), "v"(hi)); return r; }
__device__ __forceinline__ float blo(unsigned w) { return __uint_as_float(w << 16); }
__device__ __forceinline__ float bhi(unsigned w) { return __uint_as_float(w & 0xffff0000u); }
__device__ __forceinline__ float wave_sum(float v) {
#pragma unroll
    for (int o = 32; o > 0; o >>= 1) v += __shfl_xor(v, o);
    return v;
}
__device__ __forceinline__ float wave_max(float v) {
#pragma unroll
    for (int o = 32; o > 0; o >>= 1) v = fmaxf(v, __shfl_xor(v, o));
    return v;
}
__device__ __forceinline__ int row_sum_i(int v) {
    v += __builtin_amdgcn_update_dpp(0, v, 0xB1, 0xF, 0xF, false);
    v += __builtin_amdgcn_update_dpp(0, v, 0x4E, 0xF, 0xF, false);
    v += __builtin_amdgcn_update_dpp(0, v, 0x141, 0xF, 0xF, false);
    v += __builtin_amdgcn_update_dpp(0, v, 0x140, 0xF, 0xF, false);
    return v;
}
__device__ __forceinline__ float row_sum_f(float v) {
    v += __int_as_float(__builtin_amdgcn_update_dpp(0, __float_as_int(v), 0xB1, 0xF, 0xF, false));
    v += __int_as_float(__builtin_amdgcn_update_dpp(0, __float_as_int(v), 0x4E, 0xF, 0xF, false));
    v += __int_as_float(__builtin_amdgcn_update_dpp(0, __float_as_int(v), 0x141, 0xF, 0xF, false));
    v += __int_as_float(__builtin_amdgcn_update_dpp(0, __float_as_int(v), 0x140, 0xF, 0xF, false));
    return v;
}
__device__ __forceinline__ int wsum_i(int v) { v = row_sum_i(v); return __builtin_amdgcn_readlane(v, 0) + __builtin_amdgcn_readlane(v, 16) + __builtin_amdgcn_readlane(v, 32) + __builtin_amdgcn_readlane(v, 48); }
__device__ __forceinline__ float wsum_f(float v) { v = row_sum_f(v);
    return (__int_as_float(__builtin_amdgcn_readlane(__float_as_int(v), 0)) + __int_as_float(__builtin_amdgcn_readlane(__float_as_int(v), 16))) +
           (__int_as_float(__builtin_amdgcn_readlane(__float_as_int(v), 32)) + __int_as_float(__builtin_amdgcn_readlane(__float_as_int(v), 48))); }
__device__ __forceinline__ float fast_sigmoid(float x) { return __builtin_amdgcn_rcpf(1.0f + __expf(-x)); }
__device__ __forceinline__ int rel_bucket(int n) {
    if (n < 16) return n;
    const float nf = (float)n;
    int large = 16 + (int)(logf(nf / 16.0f) / 2.0794415416798357f * 16.0f);
    return large < 31 ? large : 31;
}
__device__ __forceinline__ void ld8(const bf16_t* p, float (&o)[8]) {
    const u32x4 w = *(const u32x4*)p;
    o[0] = blo(w.x); o[1] = bhi(w.x); o[2] = blo(w.y); o[3] = bhi(w.y); o[4] = blo(w.z); o[5] = bhi(w.z); o[6] = blo(w.w); o[7] = bhi(w.w);
}

#define XB_TMO      128
#define XB_XCNT(j)  (256  + 64 * (j))
#define XB_XSUB(j)  (1280 + 64 * (j))
#define XB_XGEN(j)  (2304 + 64 * (j))
#define XB_TOP      3328
#define XB_TOPGEN   3392
#define XCD_BAR_WORDS 3456
#define XB_SPIN_CAP (1u << 18)
__device__ __forceinline__ unsigned xb_ld(unsigned* p)              { return __hip_atomic_load(p, __ATOMIC_RELAXED, __HIP_MEMORY_SCOPE_AGENT); }
__device__ __forceinline__ unsigned xb_add(unsigned* p, unsigned v) { return __hip_atomic_fetch_add(p, v, __ATOMIC_RELAXED, __HIP_MEMORY_SCOPE_AGENT); }
__device__ __forceinline__ unsigned xb_xcc_id() { return (unsigned)__builtin_amdgcn_s_getreg((3 << 11) | 20) & 0xFu; }
#define XB_SPIN(cond, bar) do { unsigned _sp = 0; while (cond) { __builtin_amdgcn_s_sleep(1); \
    if ((++_sp & 255u) == 0u) { if (xb_ld(&(bar)[XB_TMO])) break; if (_sp > XB_SPIN_CAP) { atomicAdd(&(bar)[XB_TMO], 1u); break; } } } } while (0)
struct XcdBarrier { unsigned* bar; unsigned x; volatile LAS unsigned* st; };
__device__ __forceinline__ XcdBarrier xcd_barrier_post(unsigned* bar, volatile LAS unsigned* st) {
    XcdBarrier b; b.bar = bar; b.x = xb_xcc_id(); b.st = st;
    if (threadIdx.x == 0) (void)xb_add(&bar[XB_XCNT(b.x)], 1u);
    return b;
}
__device__ __forceinline__ void xcd_barrier_complete(unsigned* bar, unsigned x, unsigned& nloc, unsigned& nx) {
    const unsigned G = gridDim.x * gridDim.y * gridDim.z;
    unsigned sum, cnt, mine, sp = 0u;
    for (;;) {
        sum = 0u; cnt = 0u; mine = 0u;
#pragma unroll
        for (unsigned j = 0; j < 16; ++j) { const unsigned c = xb_ld(&bar[XB_XCNT(j)]); sum += c; cnt += (c > 0u) ? 1u : 0u; mine = (j == x) ? c : mine; }
        if (sum == G) break;
        __builtin_amdgcn_s_sleep(1);
        if ((++sp & 255u) == 0u) { if (xb_ld(&bar[XB_TMO])) break; if (sp > XB_SPIN_CAP) { atomicAdd(&bar[XB_TMO], 1u); break; } }
    }
    nloc = mine > 0u ? mine : 1u; nx = cnt > 0u ? cnt : 1u;
}
__device__ __forceinline__ void xcd_barrier(const XcdBarrier& b) {
    asm volatile("s_waitcnt vmcnt(0)" ::: "memory");
    __syncthreads();
    if (threadIdx.x == 0) {
        unsigned* bar = b.bar;
        __builtin_amdgcn_s_waitcnt(0);
        unsigned nloc = b.st[0], nx = b.st[1];
        if (nloc == 0u) { xcd_barrier_complete(bar, b.x, nloc, nx); b.st[0] = nloc; b.st[1] = nx; }
        const unsigned old = xb_add(&bar[XB_XSUB(b.x)], 1u);
        const unsigned gen = old / nloc;
        if (old + 1u == (gen + 1u) * nloc) {
            __builtin_amdgcn_fence(__ATOMIC_RELEASE, "agent");
            asm volatile("s_waitcnt vmcnt(0)" ::: "memory");
            const unsigned og = xb_add(&bar[XB_TOP], 1u);
            const unsigned tg = og / nx;
            if (og + 1u == (tg + 1u) * nx) xb_add(&bar[XB_TOPGEN], 1u);
            else XB_SPIN(xb_ld(&bar[XB_TOPGEN]) == tg, bar);
            __builtin_amdgcn_fence(__ATOMIC_ACQUIRE, "agent");
            xb_add(&bar[XB_XGEN(b.x)], 1u);
            asm volatile("s_waitcnt vmcnt(0)" ::: "memory");
        } else {
            XB_SPIN(xb_ld(&bar[XB_XGEN(b.x)]) == gen, bar);
            __builtin_amdgcn_fence(__ATOMIC_ACQUIRE, "agent");
            asm volatile("s_waitcnt vmcnt(0)" ::: "memory");
        }
    }
    __syncthreads();
}

namespace pg8 {
constexpr int BM = 256, BK = 64, HALF = 128, HTB = HALF * BK * 2, STAGE_BYTES = 8 * HTB, NXCD = 8, WGM = 8;
__host__ __device__ __forceinline__ int lds_byte(int r, int c) { const int st = (r >> 4) * 2 + (c >> 5), rr = r & 15, cc = c & 31, ob = rr * 64 + cc * 2; return st * 1024 + (ob ^ (((ob >> 9) & 1) << 5)); }
__host__ __device__ __forceinline__ void stage_rc(int b, int& R, int& C) { const int st = b / 1024, sb = b % 1024, swz = sb ^ (((sb >> 9) & 1) << 5); R = (st >> 1) * 16 + swz / 64; C = (st & 1) * 32 + (swz % 64) / 2; }
__host__ __device__ __forceinline__ int perm32(int rho) { const int n = rho >> 4, i = rho & 15; return 8 * (i >> 2) + 4 * n + (i & 3); }

struct Unit { int pn, orow, e, mt, cnt; const char* a; const char* b; };

struct DenseSched {
    const char* A; const char* Bt; int K, nM, nN, nwg, G, c;
    __device__ void init(const void* A_, const void* Bt_, int M, int N, int K_, int G_, int c_) { A = (const char*)A_; Bt = (const char*)Bt_; K = K_; nM = M / BM; nN = N / BM; nwg = nM * nN; G = G_; c = c_; }
    __device__ __forceinline__ bool next(int i, Unit& u) const {
        const long L = (long)i * G + c; if (L >= nwg) return false;
        int wgid = (int)L; { const int q = nwg / NXCD, r = nwg % NXCD, xcd = wgid % NXCD, off = wgid / NXCD; wgid = (xcd < r ? xcd * (q + 1) : r * (q + 1) + (xcd - r) * q) + off; }
        const int nig = WGM * nN, gid = wgid / nig, fm = gid * WGM, gsz = (nM - fm) < WGM ? (nM - fm) : WGM;
        const int pm = fm + ((wgid % nig) % gsz); u.pn = (wgid % nig) / gsz; u.orow = pm * BM; u.e = 0; u.mt = pm; u.cnt = BM;
        u.a = A + (size_t)pm * BM * K * 2; u.b = Bt + (size_t)u.pn * BM * K * 2; return true;
    }
    __device__ __forceinline__ void a_offs(const Unit&, const int (&R)[2], const int (&C)[2], unsigned (&aro)[2][2]) const {
#pragma unroll
        for (int h = 0; h < 2; ++h)
#pragma unroll
            for (int i = 0; i < 2; ++i) aro[h][i] = (unsigned)((h * HALF + R[i]) * K + C[i]) * 2u;
    }
};
struct MoeSched {
    const char* A; const char* Bt; const int* list; const LAS int* mtp; const LAS int* cntv; int K, Kb, G, c; bool gather; size_t bstride;
    __device__ __forceinline__ bool next(int i, Unit& u) const {
        const int L = i * G + c; const int total = mtp[NEXP] * 4; if (L >= total) return false;
        const int gm = L >> 2; u.pn = L & 3; int e = 0;
#pragma unroll 1
        for (int j = 1; j < NEXP; ++j) e += (mtp[j] <= gm) ? 1 : 0;
        u.e = e; u.mt = gm - mtp[e]; u.cnt = cntv[e]; u.orow = gm * BM;
        u.a = gather ? A : A + (size_t)gm * BM * K * 2;
        u.b = Bt + (size_t)e * bstride + (size_t)u.pn * BM * Kb * 2; return true;
    }
    __device__ __forceinline__ void a_offs(const Unit& u, const int (&R)[2], const int (&C)[2], unsigned (&aro)[2][2]) const {
#pragma unroll
        for (int h = 0; h < 2; ++h)
#pragma unroll
            for (int i = 0; i < 2; ++i) {
                if (gather) { const int pos = u.mt * BM + h * HALF + R[i]; const int tok = pos < u.cnt ? list[(size_t)u.e * LIST_CAP + pos] : 0; aro[h][i] = (unsigned)(tok * K + C[i]) * 2u; }
                else aro[h][i] = (unsigned)((h * HALF + R[i]) * K + C[i]) * 2u;
            }
    }
};

struct EpiBf16 {
    static constexpr bool PERM = true;
    bf16_t* O; int ldc;
    __device__ __forceinline__ void operator()(const f32x4 (&acc)[2][2][4][2], const Unit& u, int wr, int wc, int fr, int fq) const {
        const int row0 = u.orow + wr * 64 + fr, col0 = u.pn * BM + wc * 32 + 8 * fq;
#pragma unroll
        for (int ai = 0; ai < 2; ++ai)
#pragma unroll
            for (int m = 0; m < 4; ++m) { bf16_t* rowp = O + (size_t)(row0 + ai * HALF + m * 16) * ldc + col0;
#pragma unroll
                for (int bj = 0; bj < 2; ++bj) { const f32x4 v0 = acc[ai][bj][m][0], v1 = acc[ai][bj][m][1];
                    u32x4 w; w.x = pk2(v0[0], v0[1]); w.y = pk2(v0[2], v0[3]); w.z = pk2(v1[0], v1[1]); w.w = pk2(v1[2], v1[3]);
                    *(u32x4*)(rowp + bj * HALF) = w; } }
    }
};
struct EpiInProj {
    static constexpr bool PERM = true;
    bf16_t* O; bf16_t* VT; bf16_t* SVT;
    __device__ __forceinline__ void operator()(const f32x4 (&acc)[2][2][4][2], const Unit& u, int wr, int wc, int fr, int fq) const {
        const int row0 = u.orow + wr * 64 + fr, col0 = u.pn * BM + wc * 32 + 8 * fq;
#pragma unroll
        for (int ai = 0; ai < 2; ++ai)
#pragma unroll
            for (int m = 0; m < 4; ++m) { const int row = row0 + ai * HALF + m * 16; bf16_t* rowp = O + (size_t)row * DINP + col0;
#pragma unroll
                for (int bj = 0; bj < 2; ++bj) { const f32x4 v0 = acc[ai][bj][m][0], v1 = acc[ai][bj][m][1];
                    u32x4 w; w.x = pk2(v0[0], v0[1]); w.y = pk2(v0[2], v0[3]); w.z = pk2(v1[0], v1[1]); w.w = pk2(v1[2], v1[3]);
                    *(u32x4*)(rowp + bj * HALF) = w;
                    const int c = col0 + bj * HALF;
                    bf16_t* tp = nullptr;
                    if (c >= C_DV && c < C_DV + 64) tp = VT + ((size_t)(row >> 11) * 64 + (c - C_DV)) * SEQ + (row & (SEQ - 1));
                    else if (c >= C_SV && c < C_SV + 128) tp = SVT + ((size_t)(row >> 11) * 128 + (c - C_SV)) * SEQ + (row & (SEQ - 1));
                    if (tp) { tp[0] = (bf16_t)(w.x & 0xffffu); tp[SEQ] = (bf16_t)(w.x >> 16); tp[2 * SEQ] = (bf16_t)(w.y & 0xffffu); tp[3 * SEQ] = (bf16_t)(w.y >> 16);
                              tp[4 * SEQ] = (bf16_t)(w.z & 0xffffu); tp[5 * SEQ] = (bf16_t)(w.z >> 16); tp[6 * SEQ] = (bf16_t)(w.w & 0xffffu); tp[7 * SEQ] = (bf16_t)(w.w >> 16); } } }
    }
};
struct EpiGateUp {
    static constexpr bool PERM = true;
    bf16_t* O;
    __device__ __forceinline__ void operator()(const f32x4 (&acc)[2][2][4][2], const Unit& u, int wr, int wc, int fr, int fq) const {
        const int row0 = u.orow + wr * 64 + fr, col0 = (u.pn * BM + wc * 32 + 8 * fq) >> 1;
#pragma unroll
        for (int ai = 0; ai < 2; ++ai)
#pragma unroll
            for (int m = 0; m < 4; ++m) { bf16_t* rowp = O + (size_t)(row0 + ai * HALF + m * 16) * DEXP + col0;
#pragma unroll
                for (int bj = 0; bj < 2; ++bj) { const f32x4 v0 = acc[ai][bj][m][0], v1 = acc[ai][bj][m][1];
                    const float h0 = v0[0] * fast_sigmoid(v0[0]) * v0[1], h1 = v0[2] * fast_sigmoid(v0[2]) * v0[3];
                    const float h2 = v1[0] * fast_sigmoid(v1[0]) * v1[1], h3 = v1[2] * fast_sigmoid(v1[2]) * v1[3];
                    u32x2 w; w.x = pk2(h0, h1); w.y = pk2(h2, h3);
                    *(u32x2*)(rowp + bj * (HALF / 2)) = w; } }
    }
};
struct EpiResid {
    static constexpr bool PERM = false;
    const float* R; float* C;
    __device__ __forceinline__ void operator()(const f32x4 (&acc)[2][2][4][2], const Unit& u, int wr, int wc, int fr, int fq) const {
        const int row0 = u.orow + wr * 64 + fr, col0 = u.pn * BM + wc * 32 + 4 * fq;
#pragma unroll
        for (int ai = 0; ai < 2; ++ai)
#pragma unroll
            for (int m = 0; m < 4; ++m) { const size_t ro = (size_t)(row0 + ai * HALF + m * 16) * DM + col0;
#pragma unroll
                for (int bj = 0; bj < 2; ++bj)
#pragma unroll
                    for (int n = 0; n < 2; ++n) { const size_t o = ro + bj * HALF + n * 16; const f32x4 r = *(const f32x4*)(R + o); *(f32x4*)(C + o) = r + acc[ai][bj][m][n]; } }
    }
};
struct EpiPleGate {
    static constexpr bool PERM = false;
    float* H; const bf16_t* E; const float* erstd; const float* g;
    __device__ __forceinline__ void operator()(const f32x4 (&acc)[2][2][4][2], const Unit& u, int wr, int wc, int fr, int fq) const {
        const int row0 = u.orow + wr * 64 + fr, col0 = u.pn * BM + wc * 32 + 4 * fq;
        f32x4 gv[2][2];
#pragma unroll
        for (int bj = 0; bj < 2; ++bj)
#pragma unroll
            for (int n = 0; n < 2; ++n) gv[bj][n] = *(const f32x4*)(g + col0 + bj * HALF + n * 16);
#pragma unroll
        for (int ai = 0; ai < 2; ++ai)
#pragma unroll
            for (int m = 0; m < 4; ++m) { const int row = row0 + ai * HALF + m * 16; const size_t ro = (size_t)row * DM + col0; const float rs = erstd[row];
#pragma unroll
                for (int bj = 0; bj < 2; ++bj)
#pragma unroll
                    for (int n = 0; n < 2; ++n) { const size_t o = ro + bj * HALF + n * 16; const f32x4 h = *(const f32x4*)(H + o); const u32x2 ew = *(const u32x2*)(E + o); const f32x4 a = acc[ai][bj][m][n];
                        f32x4 r; r[0] = h[0] + blo(ew.x) * rs * gv[bj][n][0] * fast_sigmoid(a[0]); r[1] = h[1] + bhi(ew.x) * rs * gv[bj][n][1] * fast_sigmoid(a[1]);
                        r[2] = h[2] + blo(ew.y) * rs * gv[bj][n][2] * fast_sigmoid(a[2]); r[3] = h[3] + bhi(ew.y) * rs * gv[bj][n][3] * fast_sigmoid(a[3]);
                        *(f32x4*)(H + o) = r; } }
    }
};

template <class Epi, class Sched>
__device__ __forceinline__ void gemm_phase(LAS unsigned char* lds, const int K, const int Kb  , const Sched& S, const Epi& E, const int wave_id) {
    int tid_ = wave_id * 64 + (int)__builtin_amdgcn_mbcnt_hi(~0u, __builtin_amdgcn_mbcnt_lo(~0u, 0u)); asm volatile("" : "+v"(tid_));
    const int tid = tid_, wid = __builtin_amdgcn_readfirstlane(tid >> 6), lane = tid & 63, wr = wid >> 2, wc = wid & 3, fr = lane & 15, fq = lane >> 4;
    const int nt = K / BK;
    int Rr[2], Cc[2]; unsigned voffB[2];
#pragma unroll
    for (int i = 0; i < 2; ++i) { int R, C; stage_rc(tid * 16 + i * 8192, R, C); const int Rb = Epi::PERM ? ((R & ~31) + perm32(R & 31)) : R; Rr[i] = R; Cc[i] = C; voffB[i] = (unsigned)(Rb * Kb + C) * 2u; }
    const size_t kstep = (size_t)(BK * 2);
    const size_t hstepB = (size_t)HALF * Kb * 2;
    const unsigned ldsw = (unsigned)wid * 1024u;
    const int aoff = lds_byte(wr * 64 + fr, fq * 8), boff = lds_byte(wc * 32 + fr, fq * 8);
#define PG8_SA(b, h) (((b) * 2 + (h)) * HTB)
#define PG8_SB(b, h) ((4 + (b) * 2 + (h)) * HTB)
#define PG8_STAGE_B(bufoff, gbase) do { _Pragma("unroll") for (int _i = 0; _i < 2; ++_i) \
        __builtin_amdgcn_global_load_lds((const unsigned*)((const char*)(gbase) + voffB[_i]), (LAS unsigned*)(lds + (bufoff) + ldsw + _i * 8192), 16, 0, 0); } while (0)
#define PG8_STAGE_A(bufoff, gbase, o0, o1) do { \
        __builtin_amdgcn_global_load_lds((const unsigned*)((const char*)(gbase) + (o0)), (LAS unsigned*)(lds + (bufoff) + ldsw), 16, 0, 0); \
        __builtin_amdgcn_global_load_lds((const unsigned*)((const char*)(gbase) + (o1)), (LAS unsigned*)(lds + (bufoff) + ldsw + 8192), 16, 0, 0); } while (0)
#define PG8_LDA(dst, b, h) do { _Pragma("unroll") for (int m = 0; m < 4; ++m) _Pragma("unroll") for (int k = 0; k < 2; ++k) dst[m][k] = *(const LAS bf16x8*)(lds + PG8_SA(b, h) + aoff + m * 2048 + k * 1024); } while (0)
#define PG8_LDB(dst, b, h) do { _Pragma("unroll") for (int n = 0; n < 2; ++n) _Pragma("unroll") for (int k = 0; k < 2; ++k) dst[n][k] = *(const LAS bf16x8*)(lds + PG8_SB(b, h) + boff + n * 2048 + k * 1024); } while (0)
#define PG8_MMA(ai, bj, At, Bt) do { __builtin_amdgcn_s_setprio(1); _Pragma("unroll") for (int m = 0; m < 4; ++m) _Pragma("unroll") for (int n = 0; n < 2; ++n) _Pragma("unroll") for (int k = 0; k < 2; ++k) \
        acc[ai][bj][m][n] = __builtin_amdgcn_mfma_f32_16x16x32_bf16(Bt[n][k], At[m][k], acc[ai][bj][m][n], 0, 0, 0); __builtin_amdgcn_s_setprio(0); } while (0)
#define PG8_WAIT_V(n) asm volatile("s_waitcnt vmcnt(" #n ")" ::: "memory")
#define PG8_WAIT_L(n) asm volatile("s_waitcnt lgkmcnt(" #n ")" ::: "memory")
#define PG8_BAR __builtin_amdgcn_s_barrier()
#define PG8_SCHED __builtin_amdgcn_sched_barrier(0)
    Unit cur, nxt; int ui = 0;
    if (!S.next(0, cur)) return;
    f32x4 acc[2][2][4][2];
#pragma unroll
    for (int a = 0; a < 2; ++a)
#pragma unroll
        for (int b = 0; b < 2; ++b)
#pragma unroll
            for (int m = 0; m < 4; ++m)
#pragma unroll
                for (int n = 0; n < 2; ++n) acc[a][b][m][n] = (f32x4){0.f, 0.f, 0.f, 0.f};
    bf16x8 At[4][2], B0[2][2], B1[2][2];
    unsigned aroC[2][2], aroN[2][2];
    S.a_offs(cur, Rr, Cc, aroC);
    const char* cA = cur.a; const char* cB = cur.b;
    PG8_STAGE_B(PG8_SB(0, 0), cB); PG8_STAGE_A(PG8_SA(0, 0), cA, aroC[0][0], aroC[0][1]); PG8_STAGE_B(PG8_SB(0, 1), cB + hstepB); PG8_STAGE_A(PG8_SA(0, 1), cA, aroC[1][0], aroC[1][1]);
    if (wr == 1) PG8_BAR;
    PG8_WAIT_V(4); PG8_BAR;
    PG8_STAGE_B(PG8_SB(1, 0), cB + kstep); PG8_STAGE_A(PG8_SA(1, 0), cA + kstep, aroC[0][0], aroC[0][1]); PG8_STAGE_B(PG8_SB(1, 1), cB + hstepB + kstep);
    PG8_WAIT_V(6); PG8_BAR;
    for (;;) {
        const bool has_next = S.next(ui + 1, nxt);
        if (has_next) S.a_offs(nxt, Rr, Cc, aroN);
        else {
#pragma unroll
            for (int h = 0; h < 2; ++h)
#pragma unroll
                for (int i = 0; i < 2; ++i) aroN[h][i] = aroC[h][i];
        }
        const char* nA = has_next ? nxt.a : cA; const char* nB = has_next ? nxt.b : cB;
        for (int t = 0; t < nt; t += 2) {
            const bool last = (t == nt - 2);
            const char* a1 = cA + (size_t)(t + 1) * kstep;
            const char* a2 = last ? nA : cA + (size_t)(t + 2) * kstep; const char* b2 = last ? nB : cB + (size_t)(t + 2) * kstep;
            const char* a3 = a2 + kstep; const char* b3 = b2 + kstep;
            const unsigned x00 = last ? aroN[0][0] : aroC[0][0], x01 = last ? aroN[0][1] : aroC[0][1], x10 = last ? aroN[1][0] : aroC[1][0], x11 = last ? aroN[1][1] : aroC[1][1];
            PG8_LDB(B0, 0, 0); PG8_SCHED; PG8_LDA(At, 0, 0); PG8_STAGE_A(PG8_SA(1, 1), a1, aroC[1][0], aroC[1][1]);
            PG8_WAIT_L(8); PG8_BAR; PG8_WAIT_L(0); PG8_MMA(0, 0, At, B0); PG8_BAR; PG8_SCHED;
            PG8_LDB(B1, 0, 1); PG8_STAGE_B(PG8_SB(0, 0), b2);
            PG8_BAR; PG8_WAIT_L(0); PG8_MMA(0, 1, At, B1); PG8_BAR;
            PG8_LDA(At, 0, 1); PG8_STAGE_A(PG8_SA(0, 0), a2, x00, x01);
            PG8_BAR; PG8_WAIT_L(0); PG8_MMA(1, 0, At, B0); PG8_BAR; PG8_SCHED;
            PG8_STAGE_B(PG8_SB(0, 1), b2 + hstepB);
            PG8_WAIT_V(6); PG8_BAR; PG8_MMA(1, 1, At, B1); PG8_BAR;
            PG8_LDB(B0, 1, 0); PG8_SCHED; PG8_LDA(At, 1, 0); PG8_STAGE_A(PG8_SA(0, 1), a2, x10, x11);
            PG8_WAIT_L(8); PG8_BAR; PG8_WAIT_L(0); PG8_MMA(0, 0, At, B0); PG8_BAR; PG8_SCHED;
            PG8_LDB(B1, 1, 1); PG8_STAGE_B(PG8_SB(1, 0), b3);
            PG8_BAR; PG8_WAIT_L(0); PG8_MMA(0, 1, At, B1); PG8_BAR;
            PG8_LDA(At, 1, 1); PG8_STAGE_A(PG8_SA(1, 0), a3, x00, x01);
            PG8_BAR; PG8_WAIT_L(0); PG8_MMA(1, 0, At, B0); PG8_BAR; PG8_SCHED;
            PG8_STAGE_B(PG8_SB(1, 1), b3 + hstepB);
            PG8_WAIT_V(6); PG8_BAR; PG8_MMA(1, 1, At, B1); PG8_BAR;
        }
        E(acc, cur, wr, wc, fr, fq);
        if (!has_next) break;
#pragma unroll
        for (int a = 0; a < 2; ++a)
#pragma unroll
            for (int b = 0; b < 2; ++b)
#pragma unroll
                for (int m = 0; m < 4; ++m)
#pragma unroll
                    for (int n = 0; n < 2; ++n) acc[a][b][m][n] = (f32x4){0.f, 0.f, 0.f, 0.f};
        cur = nxt; cA = nA; cB = nB; ++ui;
#pragma unroll
        for (int h = 0; h < 2; ++h)
#pragma unroll
            for (int i = 0; i < 2; ++i) aroC[h][i] = aroN[h][i];
    }
    PG8_WAIT_V(0);
    if (wr == 0) PG8_BAR;
    PG8_BAR;
#undef PG8_SA
#undef PG8_SB
#undef PG8_STAGE_A
#undef PG8_STAGE_B
#undef PG8_LDA
#undef PG8_LDB
#undef PG8_MMA
#undef PG8_WAIT_V
#undef PG8_WAIT_L
#undef PG8_BAR
#undef PG8_SCHED
}
}

struct Params { const float* in[22]; float* out; unsigned char* ws; int ph_lo, ph_hi; };
struct Frame {
    LAS unsigned char* lds; int tid, lane, wave, G, bid;
    const Params* p; unsigned char* ws;
};
__device__ __forceinline__ Frame reframe(const Frame& F0) {
    Frame F = F0; int l = (int)__builtin_amdgcn_mbcnt_hi(~0u, __builtin_amdgcn_mbcnt_lo(~0u, 0u)); asm volatile("" : "+v"(l));
    F.lane = l; F.tid = F0.wave * 64 + l; return F;
}

__device__ __forceinline__ void tr_item(const float* W, int K, int N, bf16_t* WT, int rmul, int radd, LAS float* scr, int item, int lane) {
    const int nblk = (N + 31) / 32, kb = item / nblk, nb = item % nblk, k0 = 64 * kb, n0 = 32 * nb;
    const int nn = n0 + (lane & 31); const bool ok = nn < N;
#pragma unroll 8
    for (int i = 0; i < 32; ++i) { const int kk = 2 * i + (lane >> 5); float v = 0.f; if (ok) v = W[(size_t)(k0 + kk) * N + nn]; scr[kk * 33 + (lane & 31)] = v; }
    asm volatile("s_waitcnt lgkmcnt(0)" ::: "memory");
    const int c = lane & 7;
#pragma unroll
    for (int j = 0; j < 4; ++j) { const int n = (lane >> 3) + 8 * j; const LAS float* s = scr + (8 * c) * 33 + n;
        u32x4 o; o.x = pk2(s[0 * 33], s[1 * 33]); o.y = pk2(s[2 * 33], s[3 * 33]); o.z = pk2(s[4 * 33], s[5 * 33]); o.w = pk2(s[6 * 33], s[7 * 33]);
        *(u32x4*)(WT + (size_t)((n0 + n) * rmul + radd) * K + k0 + 8 * c) = o; }
    asm volatile("s_waitcnt lgkmcnt(0)" ::: "memory");
}
__device__ __forceinline__ void phase_prologue(const Frame& F0) {
    const Frame F = reframe(F0);
    LAS float* scr = (LAS float*)(F.lds + F.wave * 16384);
    const int gw = F.bid * 8 + F.wave, NGW = F.G * 8;
    constexpr int I_IN = 16 * 79, I_OUT = 16 * 32, I_G = 16 * 16, I_D = 8 * 32, I_PLE = 4 * 32, I_PG = 16 * 32;
    constexpr int PER_L = I_IN + I_OUT + NEXP * 2 * I_G + NEXP * I_D + I_PLE + I_PG;
    for (int it = gw; it < 2 * PER_L; it += NGW) {
        const int L = it / PER_L; int r = it % PER_L;
        if (r < I_IN) { tr_item(F.p->in[4] + (size_t)L * DM * DIN, DM, DIN, (bf16_t*)(F.ws + WS_WIN + L * SZ_WIN), 1, 0, scr, r, F.lane); continue; } r -= I_IN;
        if (r < I_OUT) { tr_item(F.p->in[9] + (size_t)L * DM * DM, DM, DM, (bf16_t*)(F.ws + WS_WOUT + L * SZ_WOUT), 1, 0, scr, r, F.lane); continue; } r -= I_OUT;
        if (r < NEXP * 2 * I_G) { const int e = r / (2 * I_G), w = (r / I_G) & 1, q = r % I_G;
            tr_item(F.p->in[15 + w] + ((size_t)L * NEXP + e) * DM * DEXP, DM, DEXP, (bf16_t*)(F.ws + WS_WGU + L * SZ_WGU) + (size_t)e * 1024 * DM, 2, w, scr, q, F.lane); continue; } r -= NEXP * 2 * I_G;
        if (r < NEXP * I_D) { const int e = r / I_D, q = r % I_D;
            tr_item(F.p->in[17] + ((size_t)L * NEXP + e) * DEXP * DM, DEXP, DM, (bf16_t*)(F.ws + WS_WD + L * SZ_WD) + (size_t)e * DM * DEXP, 1, 0, scr, q, F.lane); continue; } r -= NEXP * I_D;
        if (r < I_PLE) { tr_item(F.p->in[18] + (size_t)L * PLE_D * DM, PLE_D, DM, (bf16_t*)(F.ws + WS_WPLE + L * SZ_WPLE), 1, 0, scr, r, F.lane); continue; } r -= I_PLE;
        tr_item(F.p->in[20] + (size_t)L * DM * DM, DM, DM, (bf16_t*)(F.ws + WS_WPG + L * SZ_WPG), 1, 0, scr, r, F.lane);
    }
    { bf16_t* wr = (bf16_t*)(F.ws + WS_WR);
      for (int i = F.bid * NTHREADS + F.tid; i < 2 * 48 * DM; i += F.G * NTHREADS) {
          const int L = i / (48 * DM), j = (i / DM) % 48, k = i % DM;
          float w = 0.f;
          if (j < 4) w = F.p->in[11][((size_t)L * DM + k) * 4 + j]; else if (j < 36) w = F.p->in[13][((size_t)L * DM + k) * 32 + (j - 4)];
          const unsigned hi = pk2(w, 0.f) & 0xffffu; const float rem = w - bf2f(hi);
          wr[((size_t)(L * 2 + 0) * 48 + j) * DM + k] = (bf16_t)hi; wr[((size_t)(L * 2 + 1) * 48 + j) * DM + k] = (bf16_t)(pk2(rem, 0.f) & 0xffffu); } }
    const float* pin = F.p->in[1]; bf16_t* pbf = (bf16_t*)(F.ws + WS_PBF);
    const size_t n8 = (size_t)2 * T_TOK * PLE_D / 8;
    for (size_t i = (size_t)F.bid * NTHREADS + F.tid; i < n8; i += (size_t)F.G * NTHREADS) {
        const f32x4 a = *(const f32x4*)(pin + i * 8), b = *(const f32x4*)(pin + i * 8 + 4);
        u32x4 o; o.x = pk2(a[0], a[1]); o.y = pk2(a[2], a[3]); o.z = pk2(b[0], b[1]); o.w = pk2(b[2], b[3]);
        *(u32x4*)(pbf + i * 8) = o;
    }
}

__device__ __forceinline__ void phase_norm_bf16(const Frame& F0, const float* X, const float* g, bf16_t* Y) {
    const Frame F = reframe(F0);
    const int gw = F.bid * 8 + F.wave, NGW = F.G * 8;
    f32x4 gv[4];
#pragma unroll
    for (int j = 0; j < 4; ++j) gv[j] = *(const f32x4*)(g + 4 * F.lane + 256 * j);
    for (int row = gw; row < T_TOK; row += NGW) {
        const f32x4* xr = (const f32x4*)(X + (size_t)row * DM) + F.lane;
        f32x4 v[4]; float s = 0.f;
#pragma unroll
        for (int j = 0; j < 4; ++j) { v[j] = xr[64 * j]; s += v[j][0] * v[j][0] + v[j][1] * v[j][1] + v[j][2] * v[j][2] + v[j][3] * v[j][3]; }
        const float r = rsqrtf(wave_sum(s) * (1.0f / DM) + EPS);
        u32x2* o8 = (u32x2*)(Y + (size_t)row * DM) + F.lane;
#pragma unroll
        for (int j = 0; j < 4; ++j) { u32x2 o; o.x = pk2(v[j][0] * r * gv[j][0], v[j][1] * r * gv[j][1]); o.y = pk2(v[j][2] * r * gv[j][2], v[j][3] * r * gv[j][3]); o8[64 * j] = o; }
    }
}
__device__ __forceinline__ void phase_final(const Frame& F0, const float* X, const float* g, float* Y) {
    const Frame F = reframe(F0);
    const int gw = F.bid * 8 + F.wave, NGW = F.G * 8;
    f32x4 gv[4];
#pragma unroll
    for (int j = 0; j < 4; ++j) gv[j] = *(const f32x4*)(g + 4 * F.lane + 256 * j);
    for (int row = gw; row < T_TOK; row += NGW) {
        const f32x4* xr = (const f32x4*)(X + (size_t)row * DM) + F.lane;
        f32x4 v[4]; float s = 0.f;
#pragma unroll
        for (int j = 0; j < 4; ++j) { v[j] = xr[64 * j]; s += v[j][0] * v[j][0] + v[j][1] * v[j][1] + v[j][2] * v[j][2] + v[j][3] * v[j][3]; }
        const float r = rsqrtf(wave_sum(s) * (1.0f / DM) + EPS);
        f32x4* o = (f32x4*)(Y + (size_t)row * DM) + F.lane;
#pragma unroll
        for (int j = 0; j < 4; ++j) { f32x4 w; w[0] = v[j][0] * r * gv[j][0]; w[1] = v[j][1] * r * gv[j][1]; w[2] = v[j][2] * r * gv[j][2]; w[3] = v[j][3] * r * gv[j][3]; o[64 * j] = w; }
    }
}

__device__ __forceinline__ void gla_cumdecay(const Frame& F, const bf16_t* P, int tile, const float* wa, const float* ba, LAS float* bq, LAS float* tmp  ) {
    LAS float* ga = tmp; LAS float* was = tmp + 1024; LAS float* bas = tmp + 1024 + 2048;
    for (int i = F.tid; i < 1024; i += NTHREADS) { const int t = i >> 4, r = i & 15; ga[i] = bf2f(P[(size_t)(tile * 64 + t) * DINP + C_GA + r]); }
    for (int i = F.tid; i < 2048; i += NTHREADS) was[i] = wa[i];
    if (F.tid < 128) bas[F.tid] = ba[F.tid];
    __syncthreads();
#pragma unroll 4
    for (int i = 0; i < 16; ++i) {
        const int idx = F.tid + NTHREADS * i, t = idx >> 7, j = idx & 127;
        float x = 0.f;
#pragma unroll
        for (int r = 0; r < 16; ++r) x += ga[t * 16 + r] * was[r * 128 + j];
        x += bas[j];
        const float ls = fminf(x, 0.f) - log1pf(expf(-fabsf(x)));
        bq[idx] = ls * (1.0f / 16.0f);
    }
    __syncthreads();
    if (F.tid < 128) { float run = 0.f; for (int t = 0; t < 64; ++t) { run += bq[t * 128 + F.tid]; bq[t * 128 + F.tid] = run; } }
    __syncthreads();
}
__device__ __forceinline__ void gla_local(const Frame& F0, int L) {
    const Frame F = reframe(F0);
    const bf16_t* P = (const bf16_t*)(F.ws + WS_P);
    float* GU = (float*)(F.ws + WS_GU); float* GD = (float*)(F.ws + WS_GD);
    LAS float* bq = (LAS float*)F.lds;
    LAS float* kk = bq + 8192;
    LAS float* vv = kk + 8192;
    LAS float* tmp = vv + 16384;
    for (int tile = F.bid; tile < 256; tile += F.G) {
        __syncthreads();
        gla_cumdecay(F, P, tile, F.p->in[5] + L * 2048, F.p->in[6] + L * 128, bq, tmp);
        for (int c = F.tid; c < 1024; c += NTHREADS) { const int s = c >> 4, j8 = (c & 15) * 8; float f[8]; ld8(P + (size_t)(tile * 64 + s) * DINP + C_GK + j8, f);
#pragma unroll
            for (int q = 0; q < 8; ++q) kk[s * 128 + j8 + q] = f[q] * expf(bq[63 * 128 + j8 + q] - bq[s * 128 + j8 + q]); }
        for (int c = F.tid; c < 2048; c += NTHREADS) { const int s = c >> 5, j8 = (c & 31) * 8; float f[8]; ld8(P + (size_t)(tile * 64 + s) * DINP + C_GV + j8, f);
#pragma unroll
            for (int q = 0; q < 8; ++q) vv[s * 256 + j8 + q] = f[q]; }
        __syncthreads();
        const int vq = F.tid & 15, kq = (F.tid >> 4) & 7, h = F.tid >> 7;
        f32x4 u[4];
#pragma unroll
        for (int i = 0; i < 4; ++i) u[i] = (f32x4){0.f, 0.f, 0.f, 0.f};
        for (int s = 0; s < 64; ++s) {
            const f32x4 kv = *(const LAS f32x4*)(kk + s * 128 + h * 32 + kq * 4);
            const f32x4 v4 = *(const LAS f32x4*)(vv + s * 256 + h * 64 + vq * 4);
#pragma unroll
            for (int i = 0; i < 4; ++i) u[i] += kv[i] * v4;
        }
        float* up = GU + ((size_t)tile * 4 + h) * 2048 + (kq * 4) * 64 + vq * 4;
#pragma unroll
        for (int i = 0; i < 4; ++i) *(f32x4*)(up + i * 64) = u[i];
        if (F.tid < 128) GD[(size_t)tile * 128 + F.tid] = expf(bq[63 * 128 + F.tid]);
    }
}
__device__ __forceinline__ void gla_final(const Frame& F0, int L) {
    const Frame F = reframe(F0);
    const bf16_t* P = (const bf16_t*)(F.ws + WS_P);
    const float* GU = (const float*)(F.ws + WS_GU); const float* GD = (const float*)(F.ws + WS_GD);
    bf16_t* OM = (bf16_t*)(F.ws + WS_OMIX);
    const float* gnorm = F.p->in[7] + L * 64;
    LAS float* bq = (LAS float*)F.lds;
    LAS float* qtT = bq + 8192;
    LAS float* ktT = qtT + 2048;
    LAS float* vs = ktT + 2048;
    LAS float* Ss = vs + 4096;
    LAS float* AT = Ss + 2048;
    LAS float* tmp = AT + 4096;
    for (int tile = F.bid; tile < 256; tile += F.G) {
        __syncthreads();
        gla_cumdecay(F, P, tile, F.p->in[5] + L * 2048, F.p->in[6] + L * 128, bq, tmp);
        const int cb = tile & 31, tile0 = tile - cb;
        f32x4 Sp[4];
        { const int e4 = F.tid * 4, k = e4 >> 6;
#pragma unroll
          for (int h = 0; h < 4; ++h) Sp[h] = (f32x4){0.f, 0.f, 0.f, 0.f};
          int c = 0;
#pragma unroll 1
          for (; c + 4 <= cb; c += 4) {
              float d[4][4]; f32x4 u[4][4];
#pragma unroll
              for (int j = 0; j < 4; ++j)
#pragma unroll
                  for (int h = 0; h < 4; ++h) { d[j][h] = GD[(size_t)(tile0 + c + j) * 128 + h * 32 + k]; u[j][h] = *(const f32x4*)(GU + ((size_t)(tile0 + c + j) * 4 + h) * 2048 + e4); }
#pragma unroll
              for (int j = 0; j < 4; ++j)
#pragma unroll
                  for (int h = 0; h < 4; ++h) Sp[h] = Sp[h] * d[j][h] + u[j][h];
          }
#pragma unroll 1
          for (; c < cb; ++c) {
#pragma unroll
              for (int h = 0; h < 4; ++h) { const float d = GD[(size_t)(tile0 + c) * 128 + h * 32 + k]; const f32x4 u = *(const f32x4*)(GU + ((size_t)(tile0 + c) * 4 + h) * 2048 + e4); Sp[h] = Sp[h] * d + u; }
          }
        }
#pragma unroll
        for (int h = 0; h < 4; ++h) {
            *(LAS f32x4*)(Ss + F.tid * 4) = Sp[h];
            { const int t = F.tid >> 3, k4 = (F.tid & 7) * 4;
              const u32x2 qw = *(const u32x2*)(P + (size_t)(tile * 64 + t) * DINP + C_GQ + h * 32 + k4);
              const u32x2 kw = *(const u32x2*)(P + (size_t)(tile * 64 + t) * DINP + C_GK + h * 32 + k4);
              const float qf[4] = {blo(qw.x), bhi(qw.x), blo(qw.y), bhi(qw.y)}, kf[4] = {blo(kw.x), bhi(kw.x), blo(kw.y), bhi(kw.y)};
#pragma unroll
              for (int q = 0; q < 4; ++q) { const float bb = bq[t * 128 + h * 32 + k4 + q]; qtT[(k4 + q) * 64 + t] = qf[q] * 0.17677669529663687f * expf(bb); ktT[(k4 + q) * 64 + t] = kf[q] * expf(-bb); } }
            { const int s = F.tid >> 3, j8 = (F.tid & 7) * 8; float f[8]; ld8(P + (size_t)(tile * 64 + s) * DINP + C_GV + h * 64 + j8, f);
#pragma unroll
              for (int q = 0; q < 8; ++q) vs[s * 64 + j8 + q] = f[q]; }
            __syncthreads();
            const int tq = F.tid >> 4, xq = F.tid & 15;
            { f32x4 a0 = (f32x4){0.f, 0.f, 0.f, 0.f}, a1 = a0;
              for (int k = 0; k < 32; ++k) { const f32x2 q2 = *(const LAS f32x2*)(qtT + k * 64 + 2 * tq); const f32x4 k4 = *(const LAS f32x4*)(ktT + k * 64 + 4 * xq); a0 += q2[0] * k4; a1 += q2[1] * k4; }
#pragma unroll
              for (int j = 0; j < 4; ++j) { const int s = 4 * xq + j; f32x2 w; w[0] = (s <= 2 * tq) ? a0[j] : 0.f; w[1] = (s <= 2 * tq + 1) ? a1[j] : 0.f; *(LAS f32x2*)(AT + s * 64 + 2 * tq) = w; } }
            __syncthreads();
            { f32x4 o0 = (f32x4){0.f, 0.f, 0.f, 0.f}, o1 = o0;
              for (int k = 0; k < 32; ++k) { const f32x2 q2 = *(const LAS f32x2*)(qtT + k * 64 + 2 * tq); const f32x4 s4 = *(const LAS f32x4*)(Ss + k * 64 + 4 * xq); o0 += q2[0] * s4; o1 += q2[1] * s4; }
              for (int s = 0; s < 64; ++s) { const f32x2 a2 = *(const LAS f32x2*)(AT + s * 64 + 2 * tq); const f32x4 v4 = *(const LAS f32x4*)(vs + s * 64 + 4 * xq); o0 += a2[0] * v4; o1 += a2[1] * v4; }
              float s0 = o0[0] * o0[0] + o0[1] * o0[1] + o0[2] * o0[2] + o0[3] * o0[3], s1 = o1[0] * o1[0] + o1[1] * o1[1] + o1[2] * o1[2] + o1[3] * o1[3];
#pragma unroll
              for (int o = 1; o < 16; o <<= 1) { s0 += __shfl_xor(s0, o); s1 += __shfl_xor(s1, o); }
              const float r0 = rsqrtf(s0 * (1.0f / 64.0f) + EPS), r1 = rsqrtf(s1 * (1.0f / 64.0f) + EPS);
              const f32x4 gn = *(const f32x4*)(gnorm + 4 * xq);
#pragma unroll
              for (int rr = 0; rr < 2; ++rr) { const int t = 2 * tq + rr; const size_t row = (size_t)(tile * 64 + t);
                  const u32x2 gw = *(const u32x2*)(P + row * DINP + C_GG + h * 64 + 4 * xq);
                  const float gg[4] = {blo(gw.x), bhi(gw.x), blo(gw.y), bhi(gw.y)};
                  const f32x4 ov = rr ? o1 : o0; const float rs = rr ? r1 : r0;
                  float w[4];
#pragma unroll
                  for (int j = 0; j < 4; ++j) w[j] = ov[j] * rs * gn[j] * (gg[j] * fast_sigmoid(gg[j]));
                  u32x2 o; o.x = pk2(w[0], w[1]); o.y = pk2(w[2], w[3]);
                  *(u32x2*)(OM + row * DM + h * 64 + 4 * xq) = o; } }
            __syncthreads();
        }
    }
}

__device__ __forceinline__ int half_sum_i(int v, LAS int* red  , int hf, int w4) {
#pragma unroll
    for (int o = 32; o > 0; o >>= 1) v += __shfl_xor(v, o);
    __syncthreads();
    if ((threadIdx.x & 63) == 0) red[hf * 4 + w4] = v;
    __syncthreads();
    return red[hf * 4] + red[hf * 4 + 1] + red[hf * 4 + 2] + red[hf * 4 + 3];
}
__device__ __forceinline__ void dsa_simple(const Frame& F0) {
    const Frame F = reframe(F0);
    const bf16_t* P = (const bf16_t*)(F.ws + WS_P);
    bf16_t* OM = (bf16_t*)(F.ws + WS_OMIX);
    const float* rel_bias = F.p->in[2];
    const int hf = F.tid >> 8, tid = F.tid & 255, w4 = tid >> 6;
    LAS float* base = (LAS float*)(F.lds + hf * 49152);
    LAS float* qi = base;
    LAS float* qd = base + 512;
    LAS float* wq = base + 768;
    LAS float* lg = base + 1024;
    LAS unsigned* kl = (LAS unsigned*)(base + 1024 + 8192);
    LAS float* redf = base + 1024 + 8192 + 2048;
    LAS int* red = (LAS int*)(F.lds + 2 * 49152);
    for (int tile = F.bid; tile < 256; tile += F.G) {
#pragma unroll 1
        for (int it = 0; it < 32; ++it) {
            const int tg = tile * 64 + it * 2 + hf, b = tg / SEQ, t = tg % SEQ;
            __syncthreads();
            const bf16_t* pr = P + (size_t)tg * DINP;
            qi[tid] = bf2f(pr[C_IQ + tid]); qi[tid + 256] = bf2f(pr[C_IQ + 256 + tid]);
            qd[tid] = bf2f(pr[C_DQ + tid]) * 0.125f;
            if (tid < 8) wq[tid] = bf2f(pr[C_IW + tid]) * 0.04419417382415922f;
            __syncthreads();
#pragma unroll 1
            for (int i = 0; i < 8; ++i) {
                const int s = tid + 256 * i;
                unsigned key = 0u;
                if (s <= t) {
                    const bf16_t* kr = P + (size_t)(b * SEQ + s) * DINP + C_IK;
                    float sc = 0.f;
#pragma unroll 1
                    for (int h = 0; h < 8; ++h) {
                        float acc = 0.f;
#pragma unroll 2
                        for (int d = 0; d < 64; d += 8) {
                            float kv[8]; ld8(kr + d, kv);
#pragma unroll
                            for (int q = 0; q < 8; ++q) acc += qi[h * 64 + d + q] * kv[q];
                        }
                        sc += wq[h] * fmaxf(acc, 0.f);
                    }
                    sc += 0.0f;
                    const unsigned u = __float_as_uint(sc);
                    key = (u & 0x80000000u) ? ~u : (u | 0x80000000u);
                }
                kl[s] = key;
            }
            unsigned K = 0u;
#pragma unroll 1
            for (int bit = 31; bit >= 0; --bit) {
                const unsigned cand = K | (1u << bit);
                int c = 0;
#pragma unroll 1
                for (int i = 0; i < 8; ++i) c += (kl[tid + 256 * i] >= cand) ? 1 : 0;
                if (half_sum_i(c, red, hf, w4) >= 256) K = cand;
            }
            int cg = 0;
#pragma unroll 1
            for (int i = 0; i < 8; ++i) cg += (kl[tid + 256 * i] > K) ? 1 : 0;
            const int r = 256 - half_sum_i(cg, red, hf, w4);
            int lo = 0, hi = SEQ - 1;
#pragma unroll 1
            for (int itb = 0; itb < 11; ++itb) {
                const int mid = (lo + hi) >> 1;
                int c = 0;
#pragma unroll 1
                for (int i = 0; i < 8; ++i) c += (kl[tid + 256 * i] == K && (tid + 256 * i) <= mid) ? 1 : 0;
                const int tot = half_sum_i(c, red, hf, w4);
                if (lo < hi) { if (tot >= r) hi = mid; else lo = mid + 1; }
            }
            int cut = lo;
            if (t + 1 <= 256) { K = 0u; cut = SEQ; }
            float mx0 = -INFINITY, mx1 = -INFINITY, mx2 = -INFINITY, mx3 = -INFINITY;
#pragma unroll 1
            for (int i = 0; i < 8; ++i) {
                const int s = tid + 256 * i;
                const unsigned key = kl[s];
                const bool sel = (s <= t) && (key > K || (key == K && s <= cut));
                float l0 = -INFINITY, l1 = -INFINITY, l2 = -INFINITY, l3 = -INFINITY;
                if (sel) {
                    const bf16_t* kr = P + (size_t)(b * SEQ + s) * DINP + C_DK;
                    float a0 = 0.f, a1 = 0.f, a2 = 0.f, a3 = 0.f;
#pragma unroll 2
                    for (int d = 0; d < 64; d += 8) {
                        float kv[8]; ld8(kr + d, kv);
#pragma unroll
                        for (int q = 0; q < 8; ++q) { a0 += qd[d + q] * kv[q]; a1 += qd[64 + d + q] * kv[q]; a2 += qd[128 + d + q] * kv[q]; a3 += qd[192 + d + q] * kv[q]; }
                    }
                    const int bk = rel_bucket(t - s);
                    l0 = a0 + rel_bias[bk * 12 + 0]; l1 = a1 + rel_bias[bk * 12 + 1]; l2 = a2 + rel_bias[bk * 12 + 2]; l3 = a3 + rel_bias[bk * 12 + 3];
                    mx0 = fmaxf(mx0, l0); mx1 = fmaxf(mx1, l1); mx2 = fmaxf(mx2, l2); mx3 = fmaxf(mx3, l3);
                }
                lg[s] = l0; lg[2048 + s] = l1; lg[4096 + s] = l2; lg[6144 + s] = l3;
            }
            mx0 = wave_max(mx0); mx1 = wave_max(mx1); mx2 = wave_max(mx2); mx3 = wave_max(mx3);
            if ((tid & 63) == 0) { redf[w4 * 8 + 0] = mx0; redf[w4 * 8 + 1] = mx1; redf[w4 * 8 + 2] = mx2; redf[w4 * 8 + 3] = mx3; }
            __syncthreads();
            {
                const int h = tid >> 6;
                const float m = fmaxf(fmaxf(redf[h], redf[8 + h]), fmaxf(redf[16 + h], redf[24 + h]));
                float sm = 0.f;
#pragma unroll 1
                for (int s = (tid & 63); s < 2048; s += 64) { const float l = lg[h * 2048 + s]; const float e = (l == -INFINITY) ? 0.f : expf(l - m); lg[h * 2048 + s] = e; sm += e; }
                sm = wave_sum(sm);
                const int d = tid & 63;
                float acc = 0.f;
                const bf16_t* vb = P + (size_t)(b * SEQ) * DINP + C_DV + d;
#pragma unroll 1
                for (int s = 0; s <= t; ++s) {
                    const float pv = lg[h * 2048 + s];
                    if (pv != 0.f) acc += pv * bf2f(vb[(size_t)s * DINP]);
                }
                OM[(size_t)tg * DM + 256 + h * 64 + d] = (bf16_t)(pk2(acc / sm, 0.f) & 0xffffu);
            }
        }
    }
}

__device__ __forceinline__ void swa_simple(const Frame& F0, int L) {
    const Frame F = reframe(F0);
    const bf16_t* P = (const bf16_t*)(F.ws + WS_P);
    bf16_t* OM = (bf16_t*)(F.ws + WS_OMIX);
    const float* rel_bias = F.p->in[2]; const float* sinks = F.p->in[8] + L * 8;
    const int hf = F.tid >> 8, tid = F.tid & 255;
    LAS float* q = (LAS float*)(F.lds + hf * 8192);
    LAS float* lg = q + 512;
    for (int tile = F.bid; tile < 256; tile += F.G) {
        for (int it = 0; it < 32; ++it) {
            const int tg = tile * 64 + it * 2 + hf, b = tg / SEQ, t = tg % SEQ;
            __syncthreads();
            const bf16_t* pr = P + (size_t)tg * DINP;
            q[tid] = bf2f(pr[C_SQ + tid]) * 0.125f; q[tid + 256] = bf2f(pr[C_SQ + 256 + tid]) * 0.125f;
            __syncthreads();
#pragma unroll
            for (int i = 0; i < 4; ++i) {
                const int idx = tid + 256 * i, h = idx >> 7, j = idx & 127, s = t - 127 + j;
                float l = -INFINITY;
                if (s >= 0) {
                    const bf16_t* kr = P + (size_t)(b * SEQ + s) * DINP + C_SK + (h >> 2) * 64;
                    float acc = 0.f;
                    for (int d = 0; d < 64; d += 8) { float kv[8]; ld8(kr + d, kv);
#pragma unroll
                        for (int qq = 0; qq < 8; ++qq) acc += q[h * 64 + d + qq] * kv[qq]; }
                    l = acc + rel_bias[rel_bucket(127 - j) * 12 + 4 + h];
                }
                lg[idx] = l;
            }
            __syncthreads();
            {
                const int w = tid >> 6, lane = tid & 63;
#pragma unroll
                for (int hh = 0; hh < 2; ++hh) {
                    const int h = w * 2 + hh;
                    const float l0 = lg[h * 128 + lane], l1 = lg[h * 128 + 64 + lane];
                    const float sk = sinks[h];
                    const float m = fmaxf(wave_max(fmaxf(l0, l1)), sk);
                    const float e0 = expf(l0 - m), e1 = expf(l1 - m);
                    const float den = wave_sum(e0 + e1) + expf(sk - m);
                    lg[h * 128 + lane] = e0 / den; lg[h * 128 + 64 + lane] = e1 / den;
                }
            }
            __syncthreads();
#pragma unroll
            for (int i = 0; i < 2; ++i) {
                const int idx = tid + 256 * i, h = idx >> 6, d = idx & 63;
                float acc = 0.f;
                for (int j = 0; j < 128; ++j) {
                    const int s = t - 127 + j;
                    if (s >= 0) acc += lg[h * 128 + j] * bf2f(P[(size_t)(b * SEQ + s) * DINP + C_SV + (h >> 2) * 64 + d]);
                }
                OM[(size_t)tg * DM + 512 + h * 64 + d] = (bf16_t)(pk2(acc, 0.f) & 0xffffu);
            }
        }
    }
}

__device__ __forceinline__ unsigned sortable_key(float v) { const unsigned u = __float_as_uint(v + 0.0f); return (u & 0x80000000u) ? ~u : (u | 0x80000000u); }
__device__ __forceinline__ float unsortable_key(unsigned k) { return __uint_as_float((k & 0x80000000u) ? (k ^ 0x80000000u) : ~k); }
__device__ __forceinline__ bf16x8 pack8(const float (&p)[8]) {
    u32x4 w; w.x = pk2(p[0], p[1]); w.y = pk2(p[2], p[3]); w.z = pk2(p[4], p[5]); w.w = pk2(p[6], p[7]);
    return __builtin_bit_cast(bf16x8, w);
}
__device__ __forceinline__ float wmax_f(float v) {
    v = fmaxf(v, __int_as_float(__builtin_amdgcn_update_dpp(0, __float_as_int(v), 0xB1, 0xF, 0xF, false)));
    v = fmaxf(v, __int_as_float(__builtin_amdgcn_update_dpp(0, __float_as_int(v), 0x4E, 0xF, 0xF, false)));
    v = fmaxf(v, __int_as_float(__builtin_amdgcn_update_dpp(0, __float_as_int(v), 0x141, 0xF, 0xF, false)));
    v = fmaxf(v, __int_as_float(__builtin_amdgcn_update_dpp(0, __float_as_int(v), 0x140, 0xF, 0xF, false)));
    return fmaxf(fmaxf(__int_as_float(__builtin_amdgcn_readlane(__float_as_int(v), 0)), __int_as_float(__builtin_amdgcn_readlane(__float_as_int(v), 16))),
                 fmaxf(__int_as_float(__builtin_amdgcn_readlane(__float_as_int(v), 32)), __int_as_float(__builtin_amdgcn_readlane(__float_as_int(v), 48))));
}
#define S_STRIDE 2052
struct KVFrag { bf16x8 ka[2][2]; };
__device__ __forceinline__ void attn_load(const bf16_t* Kp, const int s0, const int lane, KVFrag& f) {
    const int r = lane & 15, g = lane >> 4;
#pragma unroll
    for (int blk = 0; blk < 2; ++blk) { int krow = s0 + 8 * (r >> 2) + 4 * blk + (r & 3); krow = krow < 0 ? 0 : (krow > SEQ - 1 ? SEQ - 1 : krow);
#pragma unroll
        for (int kk = 0; kk < 2; ++kk) f.ka[blk][kk] = *(const bf16x8*)(Kp + (size_t)krow * DINP + kk * 32 + 8 * g); }
}
template <int MODE, bool FAR>
__device__ __forceinline__ void attn_compute(const KVFrag& f, const bf16_t* VTp, const int s0, const int lane, const bf16x8 (&qb)[4][2], const LAS bf16x8* qlds,
                                             f32x4 (&O)[4][4], float (&mrun)[4], float (&lrun)[4], const int tbase  ,
                                             const LAS float* S, const LAS float* selK, const LAS int* selCut, const LAS float* biasRow) {
    const int g = lane >> 4;
    bf16x8 va[4];
    { const int r = lane & 15; int sv = s0 + 8 * g; sv = sv < 0 ? 0 : (sv > SEQ - 8 ? SEQ - 8 : sv);
#pragma unroll
      for (int db = 0; db < 4; ++db) va[db] = *(const bf16x8*)(VTp + (size_t)(db * 16 + r) * SEQ + sv); }
    const float bfar = biasRow[127];
#pragma unroll
    for (int cg = 0; cg < 4; ++cg) {
        f32x4 a0 = (f32x4){0.f, 0.f, 0.f, 0.f}, a1 = a0;
        const bf16x8 q0 = (MODE == 0) ? qlds[(cg * 2 + 0) * 64 + lane] : qb[cg][0], q1 = (MODE == 0) ? qlds[(cg * 2 + 1) * 64 + lane] : qb[cg][1];
        a0 = __builtin_amdgcn_mfma_f32_16x16x32_bf16(f.ka[0][0], q0, a0, 0, 0, 0); a0 = __builtin_amdgcn_mfma_f32_16x16x32_bf16(f.ka[0][1], q1, a0, 0, 0, 0);
        a1 = __builtin_amdgcn_mfma_f32_16x16x32_bf16(f.ka[1][0], q0, a1, 0, 0, 0); a1 = __builtin_amdgcn_mfma_f32_16x16x32_bf16(f.ka[1][1], q1, a1, 0, 0, 0);
        float lg[8]; bool sel[8];
        f32x4 sv0, sv1;
        const int qloc = 4 * cg + ((lane & 15) >> 2), tqc = tbase + qloc;
        float Kqc = 0.f; int cutqc = 0;
        if (MODE == 0) { sv0 = *(const LAS f32x4*)(S + qloc * S_STRIDE + s0 + 8 * g); sv1 = *(const LAS f32x4*)(S + qloc * S_STRIDE + s0 + 8 * g + 4); Kqc = selK[qloc]; cutqc = selCut[qloc]; }
        float mb = -INFINITY;
#pragma unroll
        for (int j = 0; j < 8; ++j) {
            const int sidx = s0 + 8 * g + j; const int dist = tqc - sidx;
            const float raw = (j < 4) ? a0[j & 3] : a1[j & 3];
            float bias;
            if (MODE == 0) {
                const float xs = (j < 4 ? sv0[j & 3] : sv1[j & 3]) + 0.0f;
                const bool pick = (xs > Kqc) || (xs == Kqc && sidx <= cutqc);
                if (FAR) { sel[j] = pick; bias = bfar; }
                else { sel[j] = (dist >= 0) && pick; const int dc = dist < 0 ? 0 : (dist > 127 ? 127 : dist); bias = biasRow[dc]; }
            } else { sel[j] = (dist >= 0) && (dist < 128) && (sidx >= 0); const int dc = dist < 0 ? 0 : (dist > 127 ? 127 : dist); bias = biasRow[dc]; }
            lg[j] = sel[j] ? raw * 0.125f + bias : -INFINITY;
            mb = fmaxf(mb, lg[j]);
        }
        mb = fmaxf(mb, __shfl_xor(mb, 16)); mb = fmaxf(mb, __shfl_xor(mb, 32));
        const float mn = fmaxf(mrun[cg], mb);
        const float alpha = (mn == -INFINITY) ? 1.0f : __expf(mrun[cg] - mn);
        float p[8], ps = 0.f;
#pragma unroll
        for (int j = 0; j < 8; ++j) { p[j] = sel[j] ? __expf(lg[j] - mn) : 0.f; ps += p[j]; }
        lrun[cg] = lrun[cg] * alpha + ps; mrun[cg] = mn;
        const bf16x8 pb = pack8(p);
#pragma unroll
        for (int db = 0; db < 4; ++db) { O[db][cg] = O[db][cg] * alpha; O[db][cg] = __builtin_amdgcn_mfma_f32_16x16x32_bf16(va[db], pb, O[db][cg], 0, 0, 0); }
        __builtin_amdgcn_sched_barrier(0);
    }
}

__device__ __forceinline__ void dsa_mfma(const Frame& F0) {
    const Frame F = reframe(F0);
    const bf16_t* P = (const bf16_t*)(F.ws + WS_P);
    const bf16_t* VT = (const bf16_t*)(F.ws + WS_VT);
    bf16_t* OM = (bf16_t*)(F.ws + WS_OMIX);
    const float* rel_bias = F.p->in[2];
    LAS float* S = (LAS float*)F.lds;
    LAS float* biasT = (LAS float*)(F.lds + 139264);
    LAS float* selK = (LAS float*)(F.lds + 139264 + 2048);
    LAS int* selCut = (LAS int*)(selK + 16);
    LAS float* cm = (LAS float*)(selCut + 16);
    LAS float* cl = cm + 512;
    LAS float* candv = cm + F.wave * 128;
    LAS int* candi = (LAS int*)(candv + 64);
    LAS bf16x8* qlds = (LAS bf16x8*)(F.lds + MISC_OFF + 1024);
    const int w = F.wave;
    __syncthreads();
    for (int i = F.tid; i < 512; i += NTHREADS) { const int h = i >> 7, d = i & 127; biasT[i] = rel_bias[rel_bucket(d) * 12 + h]; }
    for (int wg = F.bid; wg < 256; wg += F.G) {
        const int b = wg >> 5, ii = wg & 31;
#pragma unroll 1
        for (int sub = 0; sub < 4; ++sub) {
            int lane = F.lane; asm volatile("" : "+v"(lane));
            const int r = lane & 15, g = lane >> 4;
            const int pos = (sub == 0) ? ii : (sub == 1) ? 63 - ii : (sub == 2) ? 64 + ii : 127 - ii;
            const int t0 = pos * 16, nk = t0 + 16;
            const bf16_t* Pb = P + (size_t)b * SEQ * DINP;
            __syncthreads();
            { const int cgf = w >> 1, kkf = w & 1;
              qlds[w * 64 + lane] = *(const bf16x8*)(Pb + (size_t)(t0 + 4 * cgf + (r >> 2)) * DINP + C_DQ + (r & 3) * 64 + kkf * 32 + 8 * g); }
            {
                bf16x8 bq[8][2]; float wv[8];
                const bf16_t* qrow = Pb + (size_t)(t0 + r) * DINP;
#pragma unroll
                for (int h = 0; h < 8; ++h) { bq[h][0] = *(const bf16x8*)(qrow + C_IQ + h * 64 + 8 * g); bq[h][1] = *(const bf16x8*)(qrow + C_IQ + h * 64 + 32 + 8 * g); wv[h] = bf2f(qrow[C_IW + h]) * 0.04419417382415922f; }
                const int nblk = nk >> 4;
                int kb = w;
                bf16x8 k0 = {}, k1 = {};
                if (kb < nblk) { const bf16_t* krow = Pb + (size_t)(kb * 16 + r) * DINP + C_IK + 8 * g; k0 = *(const bf16x8*)krow; k1 = *(const bf16x8*)(krow + 32); }
#pragma unroll 1
                while (kb < nblk) {
                    const int nx = kb + 8;
                    bf16x8 n0 = k0, n1 = k1;
                    if (nx < nblk) { const bf16_t* krow = Pb + (size_t)(nx * 16 + r) * DINP + C_IK + 8 * g; n0 = *(const bf16x8*)krow; n1 = *(const bf16x8*)(krow + 32); }
                    f32x4 sc = (f32x4){0.f, 0.f, 0.f, 0.f};
#pragma unroll
                    for (int h = 0; h < 8; ++h) {
                        f32x4 a = (f32x4){0.f, 0.f, 0.f, 0.f};
                        a = __builtin_amdgcn_mfma_f32_16x16x32_bf16(k0, bq[h][0], a, 0, 0, 0); a = __builtin_amdgcn_mfma_f32_16x16x32_bf16(k1, bq[h][1], a, 0, 0, 0);
#pragma unroll
                        for (int i = 0; i < 4; ++i) sc[i] += wv[h] * fmaxf(a[i], 0.f);
                    }
                    *(LAS f32x4*)(S + r * S_STRIDE + kb * 16 + 4 * g) = sc;
                    k0 = n0; k1 = n1; kb = nx;
                }
            }
            __syncthreads();
#pragma unroll 1
            for (int qq = 0; qq < 2; ++qq) {
                const int q = 2 * w + qq, tqv = t0 + q;
                float Kf = -INFINITY; int cut = SEQ;
                if (tqv + 1 > 256) {
                    float x[32];
#pragma unroll
                    for (int c = 0; c < 8; ++c) { const int sb = 4 * lane + 256 * c;
                        f32x4 v = (f32x4){0.f, 0.f, 0.f, 0.f};
                        if (sb < nk) v = *(const LAS f32x4*)(S + q * S_STRIDE + sb);
#pragma unroll
                        for (int m = 0; m < 4; ++m) x[4 * c + m] = (sb + m <= tqv) ? (v[m] + 0.0f) : -INFINITY; }
                    float mxl = -INFINITY, mnl = INFINITY;
#pragma unroll
                    for (int i = 0; i < 32; ++i) { mxl = fmaxf(mxl, x[i]); mnl = fminf(mnl, x[i] == -INFINITY ? INFINITY : x[i]); }
                    float hi = wmax_f(mxl), lo = -wmax_f(-mnl);
                    int c_lo = tqv + 1, c_hi;
                    { int c = 0;
#pragma unroll
                      for (int i = 0; i < 32; ++i) c += (x[i] >= hi) ? 1 : 0;
                      c_hi = wsum_i(c); }
                    bool ok = c_hi < 256;
                    int iter = 0;
#pragma unroll 1
                    while (ok && (c_lo - c_hi > 48) && iter < 40) {
                        const float mid = 0.5f * lo + 0.5f * hi;
                        if (!(mid > lo && mid < hi)) { ok = false; break; }
                        int c = 0;
#pragma unroll
                        for (int i = 0; i < 32; ++i) c += (x[i] >= mid) ? 1 : 0;
                        c = wsum_i(c);
                        if (c >= 256) { lo = mid; c_lo = c; } else { hi = mid; c_hi = c; }
                        ++iter;
                    }
                    if (ok && (c_lo - c_hi <= 48)) {
                        int base = 0;
#pragma unroll
                        for (int i = 0; i < 32; ++i) {
                            const bool fl = (x[i] >= lo) && (x[i] < hi);
                            const unsigned long long mk = __ballot(fl);
                            if (mk != 0ull) { const int ps = base + __popcll(mk & ((1ull << lane) - 1ull)); if (fl) { candv[ps] = x[i]; candi[ps] = 4 * lane + 256 * (i >> 2) + (i & 3); } base += __popcll(mk); }
                        }
                        const int m = base, rt = 256 - c_hi - 1;
                        asm volatile("s_waitcnt lgkmcnt(0)" ::: "memory");
                        const float v = (lane < m) ? candv[lane] : -INFINITY; const int id = (lane < m) ? candi[lane] : 0;
                        int rank = 0;
#pragma unroll 1
                        for (int k = 0; k < m; ++k) { const float vk = candv[k]; const int ik = candi[k]; rank += ((vk > v) || (vk == v && ik < id)) ? 1 : 0; }
                        if (lane < m && rank == rt) { selK[q] = v; selCut[q] = id; }
                    } else {
                        unsigned K = 0u;
#pragma unroll 1
                        for (int bit = 31; bit >= 0; --bit) {
                            const unsigned cand = K | (1u << bit);
                            int c = 0;
#pragma unroll
                            for (int i = 0; i < 32; ++i) c += (x[i] != -INFINITY && sortable_key(x[i]) >= cand) ? 1 : 0;
                            if (wsum_i(c) >= 256) K = cand;
                        }
                        Kf = unsortable_key(K);
                        int cg_ = 0, ce_ = 0;
#pragma unroll
                        for (int i = 0; i < 32; ++i) { cg_ += (x[i] > Kf) ? 1 : 0; ce_ += (x[i] == Kf) ? 1 : 0; }
                        const int ngt = wsum_i(cg_), neq = wsum_i(ce_), rr = 256 - ngt;
                        if (neq > rr) {
                            int lo2 = 0, hi2 = SEQ - 1;
#pragma unroll 1
                            while (lo2 < hi2) {
                                const int mid = (lo2 + hi2) >> 1;
                                int c = 0;
#pragma unroll
                                for (int i = 0; i < 32; ++i) c += (x[i] == Kf && (4 * lane + 256 * (i >> 2) + (i & 3)) <= mid) ? 1 : 0;
                                if (wsum_i(c) >= rr) hi2 = mid; else lo2 = mid + 1;
                            }
                            cut = lo2;
                        }
                        if (lane == 0) { selK[q] = Kf; selCut[q] = cut; }
                    }
                } else if (lane == 0) { selK[q] = Kf; selCut[q] = cut; }
            }
            __syncthreads();
            f32x4 O[4][4]; float mrun[4], lrun[4];
            {
                bf16x8 qb[4][2];
#pragma unroll
                for (int cg = 0; cg < 4; ++cg) {
                    qb[cg][0] = (bf16x8){}; qb[cg][1] = (bf16x8){};
                    mrun[cg] = -INFINITY; lrun[cg] = 0.f;
#pragma unroll
                    for (int db = 0; db < 4; ++db) O[db][cg] = (f32x4){0.f, 0.f, 0.f, 0.f};
                }
                const LAS float* biasRow = biasT + (r & 3) * 128;
                const bf16_t* Kp = Pb + C_DK; const bf16_t* VTp = VT + (size_t)b * 64 * SEQ;
                const int nsb = (nk + 31) >> 5;
                int sb = w;
                KVFrag fa;
                if (sb < nsb) attn_load(Kp, sb * 32, lane, fa);
#pragma unroll 1
                while (sb < nsb) {
                    const int nx = sb + 8;
                    if (sb * 32 + 31 + 128 <= t0) attn_compute<0, true>(fa, VTp, sb * 32, lane, qb, qlds, O, mrun, lrun, t0, S, selK, selCut, biasRow);
                    else attn_compute<0, false>(fa, VTp, sb * 32, lane, qb, qlds, O, mrun, lrun, t0, S, selK, selCut, biasRow);
                    sb = nx; if (sb < nsb) attn_load(Kp, sb * 32, lane, fa);
                }
            }
#pragma unroll
            for (int cg = 0; cg < 4; ++cg) { lrun[cg] += __shfl_xor(lrun[cg], 16); lrun[cg] += __shfl_xor(lrun[cg], 32); }
            if (g == 0) {
#pragma unroll
                for (int cg = 0; cg < 4; ++cg) { cm[w * 64 + cg * 16 + r] = mrun[cg]; cl[w * 64 + cg * 16 + r] = lrun[cg]; }
            }
            __syncthreads();
#pragma unroll
            for (int cg = 0; cg < 4; ++cg) {
                const int col = cg * 16 + r;
                float mt = -INFINITY;
#pragma unroll
                for (int ww = 0; ww < 8; ++ww) mt = fmaxf(mt, cm[ww * 64 + col]);
                float lt = 0.f;
#pragma unroll
                for (int ww = 0; ww < 8; ++ww) { const float mw = cm[ww * 64 + col]; lt += (mw == -INFINITY) ? 0.f : cl[ww * 64 + col] * __expf(mw - mt); }
                const float f = (mrun[cg] == -INFINITY) ? 0.f : __expf(mrun[cg] - mt) / lt;
#pragma unroll
                for (int db = 0; db < 4; ++db) *(LAS f32x4*)(S + (w * 64 + col) * 68 + db * 16 + 4 * g) = O[db][cg] * f;
            }
            __syncthreads();
#pragma unroll
            for (int it = 0; it < 2; ++it) {
                const int item = (w * 64 + lane) + NTHREADS * it, col = item >> 4, d4 = (item & 15) * 4;
                f32x4 acc = (f32x4){0.f, 0.f, 0.f, 0.f};
#pragma unroll
                for (int ww = 0; ww < 8; ++ww) acc += *(const LAS f32x4*)(S + (ww * 64 + col) * 68 + d4);
                u32x2 o; o.x = pk2(acc[0], acc[1]); o.y = pk2(acc[2], acc[3]);
                *(u32x2*)(OM + (size_t)(b * SEQ + t0 + (col >> 2)) * DM + 256 + (col & 3) * 64 + d4) = o;
            }
        }
    }
}

__device__ __forceinline__ void swa_mfma(const Frame& F0, int L) {
    const Frame F = reframe(F0);
    const bf16_t* P = (const bf16_t*)(F.ws + WS_P);
    const bf16_t* SVT = (const bf16_t*)(F.ws + WS_SVT);
    bf16_t* OM = (bf16_t*)(F.ws + WS_OMIX);
    const float* rel_bias = F.p->in[2]; const float* sinks = F.p->in[8] + L * 8;
    LAS float* biasT = (LAS float*)F.lds;
    const int lane = F.lane, r = lane & 15, g = lane >> 4, w = F.wave;
    __syncthreads();
    for (int i = F.tid; i < 1024; i += NTHREADS) { const int h = i >> 7, d = i & 127; biasT[i] = rel_bias[rel_bucket(d) * 12 + 4 + h]; }
    __syncthreads();
    const int kvh = w >> 2, q0 = (w & 3) * 16, hq = kvh * 4 + (r & 3);
    const float sink = sinks[hq];
    for (int tile = F.bid; tile < 256; tile += F.G) {
        const int b = tile >> 5, t0 = (tile & 31) * 64;
        const bf16_t* Pb = P + (size_t)b * SEQ * DINP;
        f32x4 O[4][4]; float mrun[4], lrun[4]; bf16x8 qb[4][2]; int tq[4];
#pragma unroll
        for (int cg = 0; cg < 4; ++cg) {
            tq[cg] = t0 + q0 + 4 * cg + (r >> 2);
            const bf16_t* qrow = Pb + (size_t)tq[cg] * DINP + C_SQ + hq * 64 + 8 * g;
            qb[cg][0] = *(const bf16x8*)qrow; qb[cg][1] = *(const bf16x8*)(qrow + 32);
            mrun[cg] = sink; lrun[cg] = (g == 0) ? 1.0f : 0.0f;
#pragma unroll
            for (int db = 0; db < 4; ++db) O[db][cg] = (f32x4){0.f, 0.f, 0.f, 0.f};
        }
        const bf16_t* Kp = Pb + C_SK + kvh * 64; const bf16_t* VTp = SVT + ((size_t)b * 128 + kvh * 64) * SEQ;
        const int sbase = t0 + q0 - 128;
        KVFrag fa, fb;
        attn_load(Kp, sbase, lane, fa);
#pragma unroll 1
        for (int sb = 0; sb < 5; ++sb) {
            if (sb < 4) attn_load(Kp, sbase + (sb + 1) * 32, lane, fb);
            attn_compute<1, false>(fa, VTp, sbase + sb * 32, lane, qb, nullptr, O, mrun, lrun, t0 + q0, nullptr, nullptr, nullptr, biasT + hq * 128);
            fa = fb;
        }
#pragma unroll
        for (int cg = 0; cg < 4; ++cg) {
            lrun[cg] += __shfl_xor(lrun[cg], 16); lrun[cg] += __shfl_xor(lrun[cg], 32);
            const float inv = 1.0f / lrun[cg];
#pragma unroll
            for (int db = 0; db < 4; ++db) { const f32x4 o = O[db][cg] * inv; u32x2 ow; ow.x = pk2(o[0], o[1]); ow.y = pk2(o[2], o[3]);
                *(u32x2*)(OM + (size_t)(b * SEQ + tq[cg]) * DM + 512 + hq * 64 + db * 16 + 4 * g) = ow; }
        }
    }
}

__device__ __forceinline__ void phase_route(const Frame& F0, int L) {
    const Frame F = reframe(F0);
    const float* H = (const float*)(F.ws + WS_H);
    bf16_t* XN = (bf16_t*)(F.ws + WS_ABF);
    const float* g = F.p->in[10] + L * DM;
    const float* brg = F.p->in[12] + L * 4; const float* bre = F.p->in[14] + L * 32;
    const bf16_t* WRh = (const bf16_t*)(F.ws + WS_WR) + (size_t)(L * 2) * 48 * DM; const bf16_t* WRl = WRh + (size_t)48 * DM;
    unsigned* cursor = (unsigned*)(F.ws + WS_CTL) + CW_CURSOR + L * 32;
    int* list = (int*)(F.ws + WS_LIST); unsigned* slot = (unsigned*)(F.ws + WS_SLOT); float* gate = (float*)(F.ws + WS_GATE);
    LAS float* lgs = (LAS float*)F.lds;
    LAS float* rsl = lgs + 2 * 64 * 49;
    LAS int* sl_e = (LAS int*)(F.lds + MISC_OFF + 64);
    LAS int* sl_rank = sl_e + 128;
    LAS int* lcnt = sl_rank + 128;
    LAS int* gbase = lcnt + 32;
    f32x4 gv[4];
#pragma unroll
    for (int j = 0; j < 4; ++j) gv[j] = *(const f32x4*)(g + 4 * F.lane + 256 * j);
    for (int tile = F.bid; tile < 256; tile += F.G) {
        __syncthreads();
        if (F.tid < 32) lcnt[F.tid] = 0;
#pragma unroll 1
        for (int pr = 0; pr < 4; ++pr) {
            const int t0 = tile * 64 + F.wave * 8 + pr * 2;
            f32x4 xa[4], xb[4]; float sa = 0.f, sb = 0.f;
#pragma unroll
            for (int j = 0; j < 4; ++j) { xa[j] = *((const f32x4*)(H + (size_t)t0 * DM) + F.lane + 64 * j); xb[j] = *((const f32x4*)(H + (size_t)(t0 + 1) * DM) + F.lane + 64 * j);
                sa += xa[j][0] * xa[j][0] + xa[j][1] * xa[j][1] + xa[j][2] * xa[j][2] + xa[j][3] * xa[j][3]; sb += xb[j][0] * xb[j][0] + xb[j][1] * xb[j][1] + xb[j][2] * xb[j][2] + xb[j][3] * xb[j][3]; }
            const float ra = rsqrtf(wsum_f(sa) * (1.0f / DM) + EPS), rb = rsqrtf(wsum_f(sb) * (1.0f / DM) + EPS);
#pragma unroll
            for (int j = 0; j < 4; ++j) {
                u32x2 oa, ob;
                oa.x = pk2(xa[j][0] * ra * gv[j][0], xa[j][1] * ra * gv[j][1]); oa.y = pk2(xa[j][2] * ra * gv[j][2], xa[j][3] * ra * gv[j][3]);
                ob.x = pk2(xb[j][0] * rb * gv[j][0], xb[j][1] * rb * gv[j][1]); ob.y = pk2(xb[j][2] * rb * gv[j][2], xb[j][3] * rb * gv[j][3]);
                *((u32x2*)(XN + (size_t)t0 * DM) + F.lane + 64 * j) = oa; *((u32x2*)(XN + (size_t)(t0 + 1) * DM) + F.lane + 64 * j) = ob;
            }
            if (F.lane == 0) { rsl[F.wave * 8 + pr * 2] = ra; rsl[F.wave * 8 + pr * 2 + 1] = rb; }
        }
        __syncthreads();
        {
            const int rr = F.lane & 15, kg = F.lane >> 4, tgp = F.wave & 3, kh = F.wave >> 2;
            const int tok = tile * 64 + tgp * 16 + rr;
            const float rt = rsl[tgp * 16 + rr];
            f32x4 acc[3];
#pragma unroll
            for (int cb = 0; cb < 3; ++cb) acc[cb] = (f32x4){0.f, 0.f, 0.f, 0.f};
            const float* xrow = H + (size_t)tok * DM + 8 * kg;
#pragma unroll 4
            for (int ks = 16 * kh; ks < 16 * kh + 16; ++ks) {
                const f32x4 x0 = *(const f32x4*)(xrow + 32 * ks), x1 = *(const f32x4*)(xrow + 32 * ks + 4);
                const f32x4 g0 = *(const f32x4*)(g + 32 * ks + 8 * kg), g1 = *(const f32x4*)(g + 32 * ks + 8 * kg + 4);
                float v[8], lo[8];
#pragma unroll
                for (int q = 0; q < 4; ++q) { v[q] = x0[q] * rt * g0[q]; v[4 + q] = x1[q] * rt * g1[q]; }
                u32x4 hw; hw.x = pk2(v[0], v[1]); hw.y = pk2(v[2], v[3]); hw.z = pk2(v[4], v[5]); hw.w = pk2(v[6], v[7]);
                lo[0] = v[0] - blo(hw.x); lo[1] = v[1] - bhi(hw.x); lo[2] = v[2] - blo(hw.y); lo[3] = v[3] - bhi(hw.y);
                lo[4] = v[4] - blo(hw.z); lo[5] = v[5] - bhi(hw.z); lo[6] = v[6] - blo(hw.w); lo[7] = v[7] - bhi(hw.w);
                const bf16x8 Ah = __builtin_bit_cast(bf16x8, hw), Al = pack8(lo);
#pragma unroll
                for (int cb = 0; cb < 3; ++cb) {
                    const bf16x8 Bh = *(const bf16x8*)(WRh + (size_t)(16 * cb + rr) * DM + 32 * ks + 8 * kg), Bl = *(const bf16x8*)(WRl + (size_t)(16 * cb + rr) * DM + 32 * ks + 8 * kg);
                    acc[cb] = __builtin_amdgcn_mfma_f32_16x16x32_bf16(Ah, Bh, acc[cb], 0, 0, 0);
                    acc[cb] = __builtin_amdgcn_mfma_f32_16x16x32_bf16(Ah, Bl, acc[cb], 0, 0, 0);
                    acc[cb] = __builtin_amdgcn_mfma_f32_16x16x32_bf16(Al, Bh, acc[cb], 0, 0, 0);
                }
            }
#pragma unroll
            for (int cb = 0; cb < 3; ++cb)
#pragma unroll
                for (int i = 0; i < 4; ++i) lgs[(kh * 64 + tgp * 16 + 4 * kg + i) * 49 + 16 * cb + rr] = acc[cb][i];
        }
        __syncthreads();
        if (F.tid < 64) {
            const LAS float* lgp = lgs + F.tid * 49; const int t = tile * 64 + F.tid;
            float gl[4], m = -INFINITY;
#pragma unroll
            for (int j = 0; j < 4; ++j) { gl[j] = (lgp[j] + lgp[64 * 49 + j]) + brg[j]; m = fmaxf(m, gl[j]); }
            float sum = 0.f;
#pragma unroll
            for (int j = 0; j < 4; ++j) { gl[j] = expf(gl[j] - m); sum += gl[j]; }
            int gs = 0; float gw = gl[0] / sum;
#pragma unroll
            for (int j = 1; j < 4; ++j) { const float pj = gl[j] / sum; if (pj > gw) { gw = pj; gs = j; } }
            float el[8]; m = -INFINITY;
#pragma unroll
            for (int j = 0; j < 8; ++j) { el[j] = (lgp[4 + gs * 8 + j] + lgp[64 * 49 + 4 + gs * 8 + j]) + bre[gs * 8 + j]; m = fmaxf(m, el[j]); }
            sum = 0.f;
#pragma unroll
            for (int j = 0; j < 8; ++j) { el[j] = expf(el[j] - m); sum += el[j]; }
#pragma unroll
            for (int j = 0; j < 8; ++j) el[j] = el[j] / sum;
            int i1 = 0; float e1v = el[0];
#pragma unroll
            for (int j = 1; j < 8; ++j) if (el[j] > e1v) { e1v = el[j]; i1 = j; }
            int i2 = -1; float e2v = -1.f;
#pragma unroll
            for (int j = 0; j < 8; ++j) if (j != i1 && el[j] > e2v) { e2v = el[j]; i2 = j; }
            const float es = e1v + e2v;
            sl_e[2 * F.tid] = (gs * 8 + i1) & 31; sl_e[2 * F.tid + 1] = (gs * 8 + i2) & 31;
            gate[2 * t] = gw * e1v / es; gate[2 * t + 1] = gw * e2v / es;
        }
        __syncthreads();
        if (F.tid < 128) sl_rank[F.tid] = atomicAdd((int*)&lcnt[sl_e[F.tid]], 1);
        __syncthreads();
        if (F.tid < 32) gbase[F.tid] = (int)__hip_atomic_fetch_add(&cursor[F.tid], (unsigned)lcnt[F.tid], __ATOMIC_RELAXED, __HIP_MEMORY_SCOPE_AGENT);
        __syncthreads();
        if (F.tid < 128) { const int e = sl_e[F.tid], pos = gbase[e] + sl_rank[F.tid], t = tile * 64 + (F.tid >> 1);
            list[(size_t)e * LIST_CAP + pos] = t; slot[2 * t + (F.tid & 1)] = ((unsigned)e << 16) | (unsigned)pos; }
    }
}
__device__ __forceinline__ void moe_tables(const Frame& F0, int L, LAS int* cntv, LAS int* mtp) {
    const Frame F = reframe(F0);
    unsigned* cursor = (unsigned*)(F.ws + WS_CTL) + CW_CURSOR + L * 32;
    __syncthreads();
    if (F.tid < 32) cntv[F.tid] = (int)__hip_atomic_load(&cursor[F.tid], __ATOMIC_RELAXED, __HIP_MEMORY_SCOPE_AGENT);
    __syncthreads();
    if (F.tid == 0) { int run = 0; for (int e = 0; e < NEXP; ++e) { mtp[e] = run; run += (cntv[e] + 255) >> 8; } mtp[NEXP] = run; }
    __syncthreads();
}
__device__ __forceinline__ void phase_combine(const Frame& F0, int L) {
    const Frame F = reframe(F0);
    float* H = (float*)(F.ws + WS_H); bf16_t* HB = (bf16_t*)(F.ws + WS_ABF);
    const bf16_t* Y = (const bf16_t*)(F.ws + WS_P); const bf16_t* EP = (const bf16_t*)(F.ws + WS_EPRE);
    const unsigned* slot = (const unsigned*)(F.ws + WS_SLOT); const float* gate = (const float*)(F.ws + WS_GATE); float* erstd = (float*)(F.ws + WS_ERSTD);
    LAS int* cntv = (LAS int*)(F.lds + MISC_OFF + 64); LAS int* mtp = cntv + 32;
    moe_tables(F, L, cntv, mtp);
    const int gw = F.bid * 8 + F.wave, NGW = F.G * 8;
    for (int t = gw; t < T_TOK; t += NGW) {
        const unsigned s0 = slot[2 * t], s1 = slot[2 * t + 1];
        size_t r0 = (size_t)mtp[(s0 >> 16) & 31] * 256 + (s0 & 0x7fffu), r1 = (size_t)mtp[(s1 >> 16) & 31] * 256 + (s1 & 0x7fffu);
        r0 = r0 < MOE_PROWS ? r0 : 0; r1 = r1 < MOE_PROWS ? r1 : 0;
        const float g0 = gate[2 * t], g1 = gate[2 * t + 1];
        float ss = 0.f;
#pragma unroll
        for (int j = 0; j < 4; ++j) {
            const u32x2 ya = *((const u32x2*)(Y + r0 * DM) + F.lane + 64 * j), yb = *((const u32x2*)(Y + r1 * DM) + F.lane + 64 * j);
            f32x4 h = *((f32x4*)(H + (size_t)t * DM) + F.lane + 64 * j);
            h[0] += blo(ya.x) * g0 + blo(yb.x) * g1; h[1] += bhi(ya.x) * g0 + bhi(yb.x) * g1; h[2] += blo(ya.y) * g0 + blo(yb.y) * g1; h[3] += bhi(ya.y) * g0 + bhi(yb.y) * g1;
            *((f32x4*)(H + (size_t)t * DM) + F.lane + 64 * j) = h;
            u32x2 o; o.x = pk2(h[0], h[1]); o.y = pk2(h[2], h[3]);
            *((u32x2*)(HB + (size_t)t * DM) + F.lane + 64 * j) = o;
            const u32x2 ew = *((const u32x2*)(EP + (size_t)t * DM) + F.lane + 64 * j);
            ss += blo(ew.x) * blo(ew.x) + bhi(ew.x) * bhi(ew.x) + blo(ew.y) * blo(ew.y) + bhi(ew.y) * bhi(ew.y);
        }
        ss = wave_sum(ss);
        if (F.lane == 0) erstd[t] = rsqrtf(ss * (1.0f / DM) + EPS);
    }
}

#define N_PHASES (1 + 2 * 10 + 1)
#define IN(k) (lo <= (k) && (k) < hi)
#define SEAM(k) do { if (!MK_PER_PHASE && IN((k) + 1)) xcd_barrier(bar); } while (0)
template <int L>
__device__ __forceinline__ void run_layer(const Frame& F, const Params& prm, const XcdBarrier& bar, const int lo, const int hi) {
    float* H = (float*)(F.ws + WS_H);
    bf16_t* ABF = (bf16_t*)(F.ws + WS_ABF);
    const int vcu = (F.G % 8 == 0) ? (F.bid % 8) * (F.G / 8) + F.bid / 8 : F.bid;
    LAS int* cntv = (LAS int*)(F.lds + MISC_OFF + 64); LAS int* mtp = cntv + 32;
    constexpr int pb = 1 + L * 10;
    if (IN(pb + 0)) { phase_norm_bf16(F, L == 0 ? prm.in[0] : H, prm.in[3] + L * DM, ABF); SEAM(pb + 0); }
    if (IN(pb + 1)) {
        pg8::DenseSched S; S.init(ABF, F.ws + WS_WIN + L * SZ_WIN, T_TOK, DINP, DM, F.G, F.bid);
        pg8::EpiInProj E{(bf16_t*)(F.ws + WS_P), (bf16_t*)(F.ws + WS_VT), (bf16_t*)(F.ws + WS_SVT)};
        pg8::gemm_phase(F.lds, DM, DM, S, E, F.wave);
        SEAM(pb + 1);
    }
    if (IN(pb + 2)) { dsa_mfma(F); gla_local(F, L); SEAM(pb + 2); }
    if (IN(pb + 3)) { gla_final(F, L); swa_mfma(F, L); SEAM(pb + 3); }
    if (IN(pb + 4)) {
        pg8::DenseSched S; S.init(F.ws + WS_OMIX, F.ws + WS_WOUT + L * SZ_WOUT, T_TOK, DM, DM, F.G, F.bid);
        pg8::EpiResid E{L == 0 ? prm.in[0] : H, H};
        pg8::gemm_phase(F.lds, DM, DM, S, E, F.wave);
        SEAM(pb + 4);
    }
    if (IN(pb + 5)) { phase_route(F, L); SEAM(pb + 5); }
    if (IN(pb + 6)) {
        moe_tables(F, L, cntv, mtp);
        pg8::MoeSched S; S.A = (const char*)ABF; S.Bt = (const char*)(F.ws + WS_WGU + L * SZ_WGU); S.list = (const int*)(F.ws + WS_LIST); S.mtp = mtp; S.cntv = cntv;
        S.K = DM; S.Kb = DM; S.G = F.G; S.c = vcu; S.gather = true; S.bstride = (size_t)1024 * DM * 2;
        pg8::EpiGateUp E{(bf16_t*)(F.ws + WS_HMID)};
        pg8::gemm_phase(F.lds, DM, DM, S, E, F.wave);
        { const int total = mtp[NEXP] * 4, rounds = (total + F.G - 1) / F.G, nlast = total - (rounds - 1) * F.G;
          const int idle = F.G - nlast;
          if (idle == 0 || vcu >= nlast) {
              pg8::DenseSched S2; S2.init(F.ws + WS_PBF + L * SZ_PBF, F.ws + WS_WPLE + L * SZ_WPLE, T_TOK, DM, PLE_D, idle == 0 ? F.G : idle, idle == 0 ? vcu : vcu - nlast);
              pg8::EpiBf16 E2{(bf16_t*)(F.ws + WS_EPRE), DM};
              pg8::gemm_phase(F.lds, PLE_D, PLE_D, S2, E2, F.wave);
          } }
        SEAM(pb + 6);
    }
    if (IN(pb + 7)) {
        moe_tables(F, L, cntv, mtp);
        { pg8::MoeSched S; S.A = (const char*)(F.ws + WS_HMID); S.Bt = (const char*)(F.ws + WS_WD + L * SZ_WD); S.list = nullptr; S.mtp = mtp; S.cntv = cntv;
          S.K = DEXP; S.Kb = DEXP; S.G = F.G; S.c = vcu; S.gather = false; S.bstride = (size_t)DM * DEXP * 2;
          pg8::EpiBf16 E{(bf16_t*)(F.ws + WS_P), DM};
          pg8::gemm_phase(F.lds, DEXP, DEXP, S, E, F.wave); }
        SEAM(pb + 7);
    }
    if (IN(pb + 8)) { phase_combine(F, L); SEAM(pb + 8); }
    if (IN(pb + 9)) {
        pg8::DenseSched S; S.init(ABF, F.ws + WS_WPG + L * SZ_WPG, T_TOK, DM, DM, F.G, F.bid);
        pg8::EpiPleGate E{H, (const bf16_t*)(F.ws + WS_EPRE), (const float*)(F.ws + WS_ERSTD), prm.in[19] + L * DM};
        pg8::gemm_phase(F.lds, DM, DM, S, E, F.wave);
        SEAM(pb + 9);
    }
}
__global__ void __launch_bounds__(NTHREADS, 2) mk_fwd(Params prm) {
    extern __shared__ __attribute__((aligned(16))) unsigned char lds_raw[];
    Frame F; F.lds = (LAS unsigned char*)lds_raw; F.tid = threadIdx.x; F.lane = F.tid & 63; F.wave = __builtin_amdgcn_readfirstlane(F.tid >> 6);
    F.G = gridDim.x; F.bid = blockIdx.x; F.p = &prm; F.ws = prm.ws;
    volatile LAS unsigned* misc = (volatile LAS unsigned*)(F.lds + MISC_OFF);
    if (F.tid < 4) misc[F.tid] = 0u;
    __syncthreads();
    XcdBarrier bar; bar.bar = (unsigned*)(F.ws + WS_CTL) + CW_BAR; bar.x = 0; bar.st = misc;
    if (!MK_PER_PHASE) bar = xcd_barrier_post((unsigned*)(F.ws + WS_CTL) + CW_BAR, misc);
    const int lo = prm.ph_lo, hi = prm.ph_hi;
    if (IN(0)) { phase_prologue(F); SEAM(0); }
    run_layer<0>(F, prm, bar, lo, hi);
    run_layer<1>(F, prm, bar, lo, hi);
    if (IN(21)) phase_final(F, (const float*)(F.ws + WS_H), prm.in[21], prm.out);
}
#undef IN
#undef SEAM

extern "C" void kernel_launch(void* const* d_in, const int* in_sizes, int n_in, void* d_out, int out_size, void* d_ws, size_t ws_size, hipStream_t stream) {
    static int grid = 0;
    if (!grid) {
        if (n_in != 22 || ws_size < WS_END) { grid = -1; return; }
        int dev = 0, cus = 0, per_cu = 0;
        if (hipGetDevice(&dev) != hipSuccess || hipDeviceGetAttribute(&cus, hipDeviceAttributeMultiprocessorCount, dev) != hipSuccess) { grid = -1; return; }
        if (hipFuncSetAttribute((const void*)mk_fwd, hipFuncAttributeMaxDynamicSharedMemorySize, LDS_BYTES) != hipSuccess) { grid = -1; return; }
        if (hipOccupancyMaxActiveBlocksPerMultiprocessor(&per_cu, (const void*)mk_fwd, NTHREADS, LDS_BYTES) != hipSuccess || per_cu < 1) { grid = -1; return; }
        grid = cus;
        if (grid > 256) grid = 256;
    }
    if (grid < 0) return;
    (void)hipMemsetAsync((char*)d_ws + WS_CTL, 0, CTL_BYTES, stream);
    Params p{};
    for (int i = 0; i < 22; ++i) p.in[i] = (const float*)d_in[i];
    p.out = (float*)d_out; p.ws = (unsigned char*)d_ws;
#if MK_PER_PHASE
    for (int ph = 0; ph < N_PHASES; ++ph) { p.ph_lo = ph; p.ph_hi = ph + 1; hipLaunchKernelGGL(mk_fwd, dim3(grid), dim3(NTHREADS), LDS_BYTES, stream, p); }
#else
    p.ph_lo = 0; p.ph_hi = N_PHASES;
    hipLaunchKernelGGL(mk_fwd, dim3(grid), dim3(NTHREADS), LDS_BYTES, stream, p);
#endif
}
```
